# Optimizing an MI355X kernel written in HIP

```python
import math
import jax
import jax.numpy as jnp
from jax import lax
import numpy as np

D_MODEL = 2048
BATCH = 4
SEQ = 2048
DEPTH = 2

D_FF = 5632
CONV_CH = D_MODEL // 4
CONV_WIDTH = 31
MOBA_HEADS = 6
MOBA_HEAD_DIM = 128
MOBA_BLOCK = 256
MOBA_TOPK = 3
MOBA_Q_CHUNK = 32
DIFF_HEADS = 6
DIFF_QK_DIM = 64
DIFF_V_DIM = 128
DIFF_Q_BLOCK = 128
MEM_LEN = 256
MEM_HEADS = 4
MEM_HEAD_DIM = 128
N_BUCKETS = 32
MAX_DISTANCE = 128
N_BIAS_HEADS = MOBA_HEADS + DIFF_HEADS
MIX_WIDTH = CONV_CH + MOBA_HEADS * MOBA_HEAD_DIM + DIFF_HEADS * DIFF_V_DIM
PROJ_SPLITS = (CONV_CH, CONV_CH, MOBA_HEADS * MOBA_HEAD_DIM, MOBA_HEADS * MOBA_HEAD_DIM, MOBA_HEADS * MOBA_HEAD_DIM, DIFF_HEADS * 2 * DIFF_QK_DIM, DIFF_HEADS * 2 * DIFF_QK_DIM, DIFF_HEADS * DIFF_V_DIM)
PROJ_WIDTH = sum(PROJ_SPLITS)
NEG_INF = -1e30

kernel_name = "hybrid_conv_moba_diffattn_macaron"


def rms_norm(x, g, eps=1e-6):
    xf = x.astype(jnp.float32)
    y = xf * lax.rsqrt(jnp.mean(xf * xf, axis=-1, keepdims=True) + eps)
    return (y * g.astype(jnp.float32)).astype(x.dtype)


def layer_norm(x, g, b, eps=1e-5):
    xf = x.astype(jnp.float32)
    mu = jnp.mean(xf, axis=-1, keepdims=True)
    var = jnp.mean(jnp.square(xf - mu), axis=-1, keepdims=True)
    y = (xf - mu) * lax.rsqrt(var + eps)
    return (y * g.astype(jnp.float32) + b.astype(jnp.float32)).astype(x.dtype)


def swiglu(h, w_gate, w_up, w_down):
    return (jax.nn.silu(h @ w_gate) * (h @ w_up)) @ w_down


def t5_bucket(dist):
    dist = jnp.maximum(dist, 0)
    max_exact = N_BUCKETS // 2
    log_ratio = jnp.log(jnp.maximum(dist, 1).astype(jnp.float32) / max_exact) / math.log(MAX_DISTANCE / max_exact)
    large = jnp.minimum(max_exact + (log_ratio * (N_BUCKETS - max_exact)).astype(jnp.int32), N_BUCKETS - 1)
    return jnp.where(dist < max_exact, dist, large)


def conv_module(a, g, conv_w, conv_b, ln_g, ln_b):
    u = a * jax.nn.sigmoid(g)
    u = lax.conv_general_dilated(u, conv_w[:, None, :].astype(u.dtype), window_strides=(1,), padding=[(CONV_WIDTH - 1, 0)], dimension_numbers=('NWC', 'WIO', 'NWC'), feature_group_count=CONV_CH) + conv_b
    return jax.nn.silu(layer_norm(u, ln_g, ln_b))


def moba_attention(q, k, v, bias_tab):
    B, H, S, Dh = q.shape
    nb = -(-S // MOBA_BLOCK)
    pad = nb * MOBA_BLOCK - S
    kp = jnp.pad(k, ((0, 0), (0, 0), (0, pad), (0, 0)))
    vp = jnp.pad(v, ((0, 0), (0, 0), (0, pad), (0, 0)))
    kb = kp.reshape(B, H, nb, MOBA_BLOCK, Dh)
    vb = vp.reshape(B, H, nb, MOBA_BLOCK, Dh)
    counts = jnp.clip(S - jnp.arange(nb) * MOBA_BLOCK, 1, MOBA_BLOCK).astype(jnp.float32)
    kmean = jnp.sum(kb.astype(jnp.float32), axis=3) / counts[:, None]
    n_sel = min(MOBA_TOPK, nb)
    scale = Dh ** -0.5
    b_ix = jnp.arange(B)[:, None, None, None]
    h_ix = jnp.arange(H)[None, :, None, None]
    h_ix5 = jnp.arange(H)[None, :, None, None, None]
    offs = jnp.arange(MOBA_BLOCK)

    def chunk(start):
        qc = lax.dynamic_slice_in_dim(q, start, MOBA_Q_CHUNK, axis=2)
        qpos = start + jnp.arange(MOBA_Q_CHUNK)
        cur = start // MOBA_BLOCK
        gate = jnp.einsum('bhqd,bhnd->bhqn', qc.astype(jnp.float32), kmean)
        gate = jnp.where(jnp.arange(nb) < cur, gate, NEG_INF)
        _, idx = lax.top_k(gate, n_sel)
        valid = idx < cur
        k_sel = kb[b_ix, h_ix, idx]
        v_sel = vb[b_ix, h_ix, idx]
        kpos_sel = idx[..., None] * MOBA_BLOCK + offs
        bias_sel = bias_tab[h_ix5, t5_bucket(qpos[:, None, None] - kpos_sel)]
        s_sel = jnp.einsum('bhqd,bhqnjd->bhqnj', qc, k_sel).astype(jnp.float32) * scale + bias_sel
        s_sel = jnp.where(valid[..., None], s_sel, NEG_INF)
        k_own = lax.dynamic_slice_in_dim(kp, cur * MOBA_BLOCK, MOBA_BLOCK, axis=2)
        v_own = lax.dynamic_slice_in_dim(vp, cur * MOBA_BLOCK, MOBA_BLOCK, axis=2)
        kpos_own = cur * MOBA_BLOCK + offs
        dist_own = qpos[:, None] - kpos_own[None, :]
        s_own = jnp.einsum('bhqd,bhjd->bhqj', qc, k_own).astype(jnp.float32) * scale + bias_tab[:, t5_bucket(dist_own)][None]
        s_own = jnp.where(dist_own >= 0, s_own, NEG_INF)
        logits = jnp.concatenate([s_sel.reshape(B, H, MOBA_Q_CHUNK, n_sel * MOBA_BLOCK), s_own], axis=-1)
        p = jax.nn.softmax(logits, axis=-1).astype(v.dtype)
        p_sel = p[..., :n_sel * MOBA_BLOCK].reshape(B, H, MOBA_Q_CHUNK, n_sel, MOBA_BLOCK)
        p_own = p[..., n_sel * MOBA_BLOCK:]
        return jnp.einsum('bhqnj,bhqnjd->bhqd', p_sel, v_sel) + jnp.einsum('bhqj,bhjd->bhqd', p_own, v_own)

    out = lax.map(chunk, jnp.arange(0, S, MOBA_Q_CHUNK))
    return out.transpose(1, 2, 0, 3, 4).reshape(B, H, S, Dh)


def diff_attention(q, k, v, lam, lam_init, subln_g, bias_tab):
    B, H, _, S, dqk = q.shape
    scale = dqk ** -0.5
    kpos = jnp.arange(S)

    def block(start):
        qc = lax.dynamic_slice_in_dim(q, start, DIFF_Q_BLOCK, axis=3)
        qpos = start + jnp.arange(DIFF_Q_BLOCK)
        dist = qpos[:, None] - kpos[None, :]
        bias = bias_tab[:, t5_bucket(dist)]
        s = jnp.einsum('bhcqd,bhckd->bhcqk', qc, k).astype(jnp.float32) * scale + bias[None, :, None]
        s = jnp.where(dist >= 0, s, NEG_INF)
        p = jax.nn.softmax(s, axis=-1)
        a = p[:, :, 0] - lam * p[:, :, 1]
        return jnp.einsum('bhqk,bhkd->bhqd', a.astype(v.dtype), v)

    o = lax.map(block, jnp.arange(0, S, DIFF_Q_BLOCK))
    o = o.transpose(1, 2, 0, 3, 4).reshape(B, H, S, v.shape[-1])
    return rms_norm(o, subln_g) * (1.0 - lam_init)


def memory_attention(h, m, wq, wkv, q_norm, k_norm, wo):
    B, S, _ = h.shape
    M = m.shape[1]
    q = rms_norm((h @ wq).reshape(B, S, MEM_HEADS, MEM_HEAD_DIM), q_norm)
    kv = (m @ wkv).reshape(B, M, 2, MEM_HEADS, MEM_HEAD_DIM)
    k = rms_norm(kv[:, :, 0], k_norm)
    v = kv[:, :, 1]
    s = jnp.einsum('bshd,bmhd->bhsm', q, k).astype(jnp.float32) * (MEM_HEAD_DIM ** -0.5)
    p = jax.nn.softmax(s, axis=-1).astype(v.dtype)
    o = jnp.einsum('bhsm,bmhd->bshd', p, v).reshape(B, S, MEM_HEADS * MEM_HEAD_DIM)
    return o @ wo


def setup_inputs(seed: int = 0) -> dict:
    key = jax.random.key(seed)
    ks = jax.random.split(key, 32)
    L = DEPTH
    nrm = lambda k, shape, s: s * jax.random.normal(k, shape, jnp.float32)
    gain = lambda k, shape: 1.0 + 0.05 * jax.random.normal(k, shape, jnp.float32)
    return {
        "x": nrm(ks[0], (BATCH, SEQ, D_MODEL), 1.0),
        "mem": nrm(ks[1], (BATCH, MEM_LEN, D_MODEL), 1.0),
        "rel_bias": nrm(ks[2], (N_BUCKETS, N_BIAS_HEADS), 0.5),
        "ffn1_norm": gain(ks[3], (L, D_MODEL)),
        "ffn1_w_gate": nrm(ks[4], (L, D_MODEL, D_FF), D_MODEL ** -0.5),
        "ffn1_w_up": nrm(ks[5], (L, D_MODEL, D_FF), D_MODEL ** -0.5),
        "ffn1_w_down": nrm(ks[6], (L, D_FF, D_MODEL), D_FF ** -0.5),
        "mix_norm": gain(ks[7], (L, D_MODEL)),
        "w_in": nrm(ks[8], (L, D_MODEL, PROJ_WIDTH), D_MODEL ** -0.5),
        "conv_w": nrm(ks[9], (L, CONV_WIDTH, CONV_CH), CONV_WIDTH ** -0.5),
        "conv_b": nrm(ks[10], (L, CONV_CH), 0.02),
        "conv_ln_g": gain(ks[11], (L, CONV_CH)),
        "conv_ln_b": nrm(ks[12], (L, CONV_CH), 0.02),
        "moba_q_norm": gain(ks[13], (L, MOBA_HEAD_DIM)),
        "moba_k_norm": gain(ks[14], (L, MOBA_HEAD_DIM)),
        "diff_q_norm": gain(ks[15], (L, DIFF_QK_DIM)),
        "diff_k_norm": gain(ks[16], (L, DIFF_QK_DIM)),
        "diff_lambda": nrm(ks[17], (L, 4, DIFF_QK_DIM), 0.1),
        "diff_subln": gain(ks[18], (L, DIFF_V_DIM)),
        "w_out": nrm(ks[19], (L, MIX_WIDTH, D_MODEL), MIX_WIDTH ** -0.5),
        "mem_norm_x": gain(ks[20], (L, D_MODEL)),
        "mem_norm_m": gain(ks[21], (L, D_MODEL)),
        "mem_wq": nrm(ks[22], (L, D_MODEL, MEM_HEADS * MEM_HEAD_DIM), D_MODEL ** -0.5),
        "mem_wkv": nrm(ks[23], (L, D_MODEL, 2 * MEM_HEADS * MEM_HEAD_DIM), D_MODEL ** -0.5),
        "mem_q_norm": gain(ks[24], (L, MEM_HEAD_DIM)),
        "mem_k_norm": gain(ks[25], (L, MEM_HEAD_DIM)),
        "mem_wo": nrm(ks[26], (L, MEM_HEADS * MEM_HEAD_DIM, D_MODEL), (MEM_HEADS * MEM_HEAD_DIM) ** -0.5),
        "ffn2_norm": gain(ks[27], (L, D_MODEL)),
        "ffn2_w_gate": nrm(ks[28], (L, D_MODEL, D_FF), D_MODEL ** -0.5),
        "ffn2_w_up": nrm(ks[29], (L, D_MODEL, D_FF), D_MODEL ** -0.5),
        "ffn2_w_down": nrm(ks[30], (L, D_FF, D_MODEL), D_FF ** -0.5),
    }


def reference(x, mem, rel_bias, ffn1_norm, ffn1_w_gate, ffn1_w_up, ffn1_w_down, mix_norm, w_in, conv_w, conv_b, conv_ln_g, conv_ln_b, moba_q_norm, moba_k_norm, diff_q_norm, diff_k_norm, diff_lambda, diff_subln, w_out, mem_norm_x, mem_norm_m, mem_wq, mem_wkv, mem_q_norm, mem_k_norm, mem_wo, ffn2_norm, ffn2_w_gate, ffn2_w_up, ffn2_w_down):
    B, S, _ = x.shape
    split_points = np.cumsum(PROJ_SPLITS)[:-1].tolist()
    bias_t = rel_bias.T
    moba_bias = bias_t[:MOBA_HEADS]
    diff_bias = bias_t[MOBA_HEADS:]
    for l in range(DEPTH):
        x = x + 0.5 * swiglu(rms_norm(x, ffn1_norm[l]), ffn1_w_gate[l], ffn1_w_up[l], ffn1_w_down[l])
        h = rms_norm(x, mix_norm[l])
        proj = h @ w_in[l]
        ca, cg, mq, mk, mv, dq, dk, dv = jnp.split(proj, split_points, axis=-1)
        y_conv = conv_module(ca, cg, conv_w[l], conv_b[l], conv_ln_g[l], conv_ln_b[l])
        mq = rms_norm(mq.reshape(B, S, MOBA_HEADS, MOBA_HEAD_DIM), moba_q_norm[l]).transpose(0, 2, 1, 3)
        mk = rms_norm(mk.reshape(B, S, MOBA_HEADS, MOBA_HEAD_DIM), moba_k_norm[l]).transpose(0, 2, 1, 3)
        mv = mv.reshape(B, S, MOBA_HEADS, MOBA_HEAD_DIM).transpose(0, 2, 1, 3)
        y_moba = moba_attention(mq, mk, mv, moba_bias).transpose(0, 2, 1, 3).reshape(B, S, MOBA_HEADS * MOBA_HEAD_DIM)
        dq = rms_norm(dq.reshape(B, S, DIFF_HEADS, 2, DIFF_QK_DIM), diff_q_norm[l]).transpose(0, 2, 3, 1, 4)
        dk = rms_norm(dk.reshape(B, S, DIFF_HEADS, 2, DIFF_QK_DIM), diff_k_norm[l]).transpose(0, 2, 3, 1, 4)
        dv = dv.reshape(B, S, DIFF_HEADS, DIFF_V_DIM).transpose(0, 2, 1, 3)
        lam_init = 0.8 - 0.6 * math.exp(-0.3 * l)
        lp = diff_lambda[l].astype(jnp.float32)
        lam = jnp.exp(jnp.sum(lp[0] * lp[1])) - jnp.exp(jnp.sum(lp[2] * lp[3])) + lam_init
        y_diff = diff_attention(dq, dk, dv, lam, lam_init, diff_subln[l], diff_bias)
        y_diff = y_diff.transpose(0, 2, 1, 3).reshape(B, S, DIFF_HEADS * DIFF_V_DIM)
        x = x + jnp.concatenate([y_conv, y_moba, y_diff], axis=-1) @ w_out[l]
        x = x + memory_attention(rms_norm(x, mem_norm_x[l]), rms_norm(mem, mem_norm_m[l]), mem_wq[l], mem_wkv[l], mem_q_norm[l], mem_k_norm[l], mem_wo[l])
        x = x + 0.5 * swiglu(rms_norm(x, ffn2_norm[l]), ffn2_w_gate[l], ffn2_w_up[l], ffn2_w_down[l])
    return x
```

```cpp
#include <hip/hip_runtime.h>
#include <hip/hip_cooperative_groups.h>
#include <cstdio>
namespace cg = cooperative_groups;

#define LAS __attribute__((address_space(3)))
typedef _Float16 hf;
typedef _Float16 h8 __attribute__((ext_vector_type(8)));
typedef _Float16 h4 __attribute__((ext_vector_type(4)));
typedef float f32x4 __attribute__((ext_vector_type(4)));

constexpr int DM = 2048, NB = 4, SQ = 2048, MT = NB * SQ, DFF = 5632, PW = 5632, NL = 2;
constexpr int CONVC = 512, CONVW = 31, MEML = 256;
constexpr float LOG2E = 1.4426950408889634f;
constexpr float NEGV = -1e30f;
constexpr int LDS_BYTES = 147456;

constexpr size_t E_GU = (size_t)2 * DFF * DM, E_DN = (size_t)DM * DFF, E_WIN = (size_t)PW * DM, E_WOUT = (size_t)DM * DM, E_WQ = (size_t)512 * DM, E_WKV = (size_t)1024 * DM, E_WO = (size_t)DM * 512;
constexpr size_t O_GU1 = 0, O_DN1 = O_GU1 + E_GU, O_WIN = O_DN1 + E_DN, O_WOUT = O_WIN + E_WIN, O_WQ = O_WOUT + E_WOUT, O_WKV = O_WQ + E_WQ, O_WO = O_WKV + E_WKV, O_GU2 = O_WO + E_WO, O_DN2 = O_GU2 + E_GU, E_LAYER = O_DN2 + E_DN;
constexpr size_t WS_W = 0;
constexpr size_t WS_H = WS_W + 2 * E_LAYER * 2;
constexpr size_t WS_BIG = WS_H + (size_t)MT * DM * 2;
constexpr size_t WS_U = WS_BIG + (size_t)MT * PW * 4;
constexpr size_t WS_MQ = WS_U + (size_t)MT * 512 * 4;
constexpr size_t WS_MK = WS_MQ + (size_t)MT * 768 * 2;
constexpr size_t WS_MVT = WS_MK + (size_t)MT * 768 * 2;
constexpr size_t WS_DQ = WS_MVT + (size_t)MT * 768 * 2;
constexpr size_t WS_DK = WS_DQ + (size_t)MT * 768 * 2;
constexpr size_t WS_DVT = WS_DK + (size_t)MT * 768 * 2;
constexpr size_t WS_YCAT = WS_DVT + (size_t)MT * 768 * 2;
constexpr size_t WS_KPART = WS_YCAT + (size_t)MT * DM * 2;
constexpr size_t WS_MEMH = WS_KPART + (size_t)4 * 64 * 768 * 4;
constexpr size_t WS_MEMKV = WS_MEMH + (size_t)2 * 1024 * DM * 2;
constexpr size_t WS_MEMK = WS_MEMKV + (size_t)2 * 1024 * 1024 * 4;
constexpr size_t WS_MEMVT = WS_MEMK + (size_t)2 * 1024 * 512 * 2;
constexpr size_t WS_OMEM = WS_MEMVT + (size_t)2 * 1024 * 512 * 2;
constexpr size_t WS_CNT = WS_OMEM + (size_t)MT * 512 * 2;
constexpr size_t WS_END = WS_CNT + 256;

struct Params {
    const float* in[31];
    float* out;
    unsigned char* ws;
    int ph_lo, ph_hi;
};

namespace pg8 {
constexpr int BM = 256, BK = 64, HALF = 128, HTB = HALF * BK * 2, STAGE_BYTES = 8 * HTB, NXCD = 8, WGM = 8;
__host__ __device__ __forceinline__ int lds_byte(int r, int c) { const int st = (r >> 4) * 2 + (c >> 5), rr = r & 15, cc = c & 31, ob = rr * 64 + cc * 2; return st * 1024 + (ob ^ (((ob >> 9) & 1) << 5)); }
__host__ __device__ __forceinline__ void stage_rc(int b, int& R, int& C) { const int st = b / 1024, sb = b % 1024, swz = sb ^ (((sb >> 9) & 1) << 5); R = (st >> 1) * 16 + swz / 64; C = (st & 1) * 32 + (swz % 64) / 2; }
__host__ __device__ __forceinline__ int perm32(int rho) { const int n = rho >> 4, i = rho & 15; return 8 * (i >> 2) + 4 * n + (i & 3); }
struct Unit { int pm, pn; };
struct Gemm { const hf* A; const hf* Bt; int M, N, K; };
struct StaticOrder {
    int nM, nN, nwg, G, c;
    __device__ void init(int M, int N, int G_, int c_) { nM = M / BM; nN = N / BM; nwg = nM * nN; G = G_; c = c_; }
    __device__ bool next(int i, Unit& u) const {
        const long L = (long)i * G + c; if (L >= nwg) return false;
        int wgid = (int)L; { const int q = nwg / NXCD, r = nwg % NXCD, xcd = wgid % NXCD, off = wgid / NXCD; wgid = (xcd < r ? xcd * (q + 1) : r * (q + 1) + (xcd - r) * q) + off; }
        const int nig = WGM * nN, gid = wgid / nig, fm = gid * WGM, gsz = (nM - fm) < WGM ? (nM - fm) : WGM;
        u.pm = fm + ((wgid % nig) % gsz); u.pn = (wgid % nig) / gsz; return true;
    }
};
struct EpiF32 {
    static constexpr bool PERM = false;
    float* C; int ldc;
    __device__ __forceinline__ void operator()(const f32x4 (&acc)[2][2][4][2], const Unit& u, int wr, int wc, int fr, int fq) const {
        const int row0 = u.pm * BM + wr * 64 + fr, col0 = u.pn * BM + wc * 32 + 4 * fq;
#pragma unroll
        for (int ai = 0; ai < 2; ++ai)
#pragma unroll
            for (int m = 0; m < 4; ++m) { float* rowp = C + (size_t)(row0 + ai * HALF + m * 16) * ldc + col0;
#pragma unroll
                for (int bj = 0; bj < 2; ++bj)
#pragma unroll
                    for (int n = 0; n < 2; ++n) *(f32x4*)(rowp + bj * HALF + n * 16) = acc[ai][bj][m][n]; }
    }
};
struct EpiRes {
    static constexpr bool PERM = false;
    const float* base; float* out; int ldc; float scale;
    __device__ __forceinline__ void operator()(const f32x4 (&acc)[2][2][4][2], const Unit& u, int wr, int wc, int fr, int fq) const {
        const int row0 = u.pm * BM + wr * 64 + fr, col0 = u.pn * BM + wc * 32 + 4 * fq;
#pragma unroll
        for (int ai = 0; ai < 2; ++ai)
#pragma unroll
            for (int m = 0; m < 4; ++m) { const size_t off = (size_t)(row0 + ai * HALF + m * 16) * ldc + col0;
#pragma unroll
                for (int bj = 0; bj < 2; ++bj)
#pragma unroll
                    for (int n = 0; n < 2; ++n) { const f32x4 b = *(const f32x4*)(base + off + bj * HALF + n * 16); *(f32x4*)(out + off + bj * HALF + n * 16) = b + acc[ai][bj][m][n] * scale; }
                asm volatile("" ::: "memory"); }
    }
};
struct EpiSwiGLU {
    static constexpr bool PERM = true;
    hf* O; int ldc;
    __device__ __forceinline__ void operator()(const f32x4 (&acc)[2][2][4][2], const Unit& u, int wr, int wc, int fr, int fq) const {
        const int row0 = u.pm * BM + wr * 64 + fr, col0 = u.pn * HALF + wc * 32 + 8 * fq;
#pragma unroll
        for (int ai = 0; ai < 2; ++ai)
#pragma unroll
            for (int m = 0; m < 4; ++m) { hf* rowp = O + (size_t)(row0 + ai * HALF + m * 16) * ldc + col0; h8 w;
#pragma unroll
                for (int n = 0; n < 2; ++n)
#pragma unroll
                    for (int j = 0; j < 4; ++j) { const float g = acc[ai][0][m][n][j], up = acc[ai][1][m][n][j]; const float s = g / (1.0f + __expf(-g)); w[n * 4 + j] = (hf)(s * up); }
                *(h8*)rowp = w; }
    }
};

template <class Epi, class Sched>
__device__ __forceinline__ void gemm_phase(LAS unsigned char* lds, const Gemm g, const Sched& S, const Epi& E) {
    int tid = threadIdx.x; asm volatile("" : "+v"(tid));
    const int wid = __builtin_amdgcn_readfirstlane(tid >> 6), lane = tid & 63, wr = wid >> 2, wc = wid & 3, fr = lane & 15, fq = lane >> 4;
    const int K = g.K, nt = K / BK;
    unsigned voffA[2], voffB[2];
#pragma unroll
    for (int i = 0; i < 2; ++i) { int R, C; stage_rc(tid * 16 + i * 8192, R, C); const int Rb = Epi::PERM ? ((R & ~31) + perm32(R & 31)) : R;
        voffA[i] = (unsigned)(R * K + C) * 2u; voffB[i] = (unsigned)(Rb * K + C) * 2u; }
    const size_t kstep = (size_t)(BK * 2);
    const size_t hstep = (size_t)HALF * K * 2;
    const size_t tstep = 2 * hstep;
    const unsigned ldsw = (unsigned)wid * 1024u;
    const int aoff = lds_byte(wr * 64 + fr, fq * 8), boff = lds_byte(wc * 32 + fr, fq * 8);
#define PG8_SA(b, h) (((b) * 2 + (h)) * HTB)
#define PG8_SB(b, h) ((4 + (b) * 2 + (h)) * HTB)
#define PG8_STAGE(bufoff, gbase, voff) do { _Pragma("unroll") for (int _i = 0; _i < 2; ++_i) \
        __builtin_amdgcn_global_load_lds((const unsigned*)((const char*)(gbase) + (voff)[_i]), (LAS unsigned*)(lds + (bufoff) + ldsw + _i * 8192), 16, 0, 0); } while (0)
#define PG8_LDA(dst, b, h) do { _Pragma("unroll") for (int m = 0; m < 4; ++m) _Pragma("unroll") for (int k = 0; k < 2; ++k) dst[m][k] = *(const LAS h8*)(lds + PG8_SA(b, h) + aoff + m * 2048 + k * 1024); } while (0)
#define PG8_LDB(dst, b, h) do { _Pragma("unroll") for (int n = 0; n < 2; ++n) _Pragma("unroll") for (int k = 0; k < 2; ++k) dst[n][k] = *(const LAS h8*)(lds + PG8_SB(b, h) + boff + n * 2048 + k * 1024); } while (0)
#define PG8_MMA(ai, bj, At, Bt) do { __builtin_amdgcn_s_setprio(1); _Pragma("unroll") for (int m = 0; m < 4; ++m) _Pragma("unroll") for (int n = 0; n < 2; ++n) _Pragma("unroll") for (int k = 0; k < 2; ++k) \
        acc[ai][bj][m][n] = __builtin_amdgcn_mfma_f32_16x16x32_f16(Bt[n][k], At[m][k], acc[ai][bj][m][n], 0, 0, 0); __builtin_amdgcn_s_setprio(0); } while (0)
#define PG8_WAIT_V(n) asm volatile("s_waitcnt vmcnt(" #n ")" ::: "memory")
#define PG8_WAIT_L(n) asm volatile("s_waitcnt lgkmcnt(" #n ")" ::: "memory")
#define PG8_BAR __builtin_amdgcn_s_barrier()
#define PG8_SCHED __builtin_amdgcn_sched_barrier(0)
    Unit cur, nxt; int ui = 0;
    if (!S.next(0, cur)) return;
    f32x4 acc[2][2][4][2];
#pragma unroll
    for (int a = 0; a < 2; ++a)
#pragma unroll
        for (int b = 0; b < 2; ++b)
#pragma unroll
            for (int m = 0; m < 4; ++m)
#pragma unroll
                for (int n = 0; n < 2; ++n) acc[a][b][m][n] = (f32x4){0.f, 0.f, 0.f, 0.f};
    h8 At[4][2], B0[2][2], B1[2][2];
    const char* cA = (const char*)g.A + (size_t)cur.pm * tstep; const char* cB = (const char*)g.Bt + (size_t)cur.pn * tstep;
    PG8_STAGE(PG8_SB(0, 0), cB, voffB); PG8_STAGE(PG8_SA(0, 0), cA, voffA); PG8_STAGE(PG8_SB(0, 1), cB + hstep, voffB); PG8_STAGE(PG8_SA(0, 1), cA + hstep, voffA);
    if (wr == 1) PG8_BAR;
    PG8_WAIT_V(4); PG8_BAR;
    PG8_STAGE(PG8_SB(1, 0), cB + kstep, voffB); PG8_STAGE(PG8_SA(1, 0), cA + kstep, voffA); PG8_STAGE(PG8_SB(1, 1), cB + hstep + kstep, voffB);
    PG8_WAIT_V(6); PG8_BAR;
    for (;;) {
        const bool has_next = S.next(ui + 1, nxt);
        const char* nA = has_next ? (const char*)g.A + (size_t)nxt.pm * tstep : cA; const char* nB = has_next ? (const char*)g.Bt + (size_t)nxt.pn * tstep : cB;
        for (int t = 0; t < nt; t += 2) {
            const bool last = (t == nt - 2);
            const char* a1 = cA + (size_t)(t + 1) * kstep;
            const char* a2 = last ? nA : cA + (size_t)(t + 2) * kstep; const char* b2 = last ? nB : cB + (size_t)(t + 2) * kstep;
            const char* a3 = a2 + kstep; const char* b3 = b2 + kstep;
            PG8_LDB(B0, 0, 0); PG8_SCHED; PG8_LDA(At, 0, 0); PG8_STAGE(PG8_SA(1, 1), a1 + hstep, voffA);
            PG8_WAIT_L(8); PG8_BAR; PG8_WAIT_L(0); PG8_MMA(0, 0, At, B0); PG8_BAR; PG8_SCHED;
            PG8_LDB(B1, 0, 1); PG8_STAGE(PG8_SB(0, 0), b2, voffB);
            PG8_BAR; PG8_WAIT_L(0); PG8_MMA(0, 1, At, B1); PG8_BAR;
            PG8_LDA(At, 0, 1); PG8_STAGE(PG8_SA(0, 0), a2, voffA);
            PG8_BAR; PG8_WAIT_L(0); PG8_MMA(1, 0, At, B0); PG8_BAR; PG8_SCHED;
            PG8_STAGE(PG8_SB(0, 1), b2 + hstep, voffB);
            PG8_WAIT_V(6); PG8_BAR; PG8_MMA(1, 1, At, B1); PG8_BAR;
            PG8_LDB(B0, 1, 0); PG8_SCHED; PG8_LDA(At, 1, 0); PG8_STAGE(PG8_SA(0, 1), a2 + hstep, voffA);
            PG8_WAIT_L(8); PG8_BAR; PG8_WAIT_L(0); PG8_MMA(0, 0, At, B0); PG8_BAR; PG8_SCHED;
            PG8_LDB(B1, 1, 1); PG8_STAGE(PG8_SB(1, 0), b3, voffB);
            PG8_BAR; PG8_WAIT_L(0); PG8_MMA(0, 1, At, B1); PG8_BAR;
            PG8_LDA(At, 1, 1); PG8_STAGE(PG8_SA(1, 0), a3, voffA);
            PG8_BAR; PG8_WAIT_L(0); PG8_MMA(1, 0, At, B0); PG8_BAR; PG8_SCHED;
            PG8_STAGE(PG8_SB(1, 1), b3 + hstep, voffB);
            PG8_WAIT_V(6); PG8_BAR; PG8_MMA(1, 1, At, B1); PG8_BAR;
        }
        E(acc, cur, wr, wc, fr, fq);
        if (!has_next) break;
#pragma unroll
        for (int a = 0; a < 2; ++a)
#pragma unroll
            for (int b = 0; b < 2; ++b)
#pragma unroll
                for (int m = 0; m < 4; ++m)
#pragma unroll
                    for (int n = 0; n < 2; ++n) acc[a][b][m][n] = (f32x4){0.f, 0.f, 0.f, 0.f};
        cur = nxt; cA = nA; cB = nB; ++ui;
    }
    PG8_WAIT_V(0);
    if (wr == 0) PG8_BAR;
    PG8_BAR;
#undef PG8_SA
#undef PG8_SB
#undef PG8_STAGE
#undef PG8_LDA
#undef PG8_LDB
#undef PG8_MMA
#undef PG8_WAIT_V
#undef PG8_WAIT_L
#undef PG8_BAR
#undef PG8_SCHED
}
}

__device__ __forceinline__ int otid() { int t = threadIdx.x; asm volatile("" : "+v"(t)); return t; }
__device__ __forceinline__ float wave_sum(float v) {
#pragma unroll
    for (int o = 32; o >= 1; o >>= 1) v += __shfl_xor(v, o);
    return v;
}
__device__ __forceinline__ float sigmoidf_(float x) { return 1.0f / (1.0f + __expf(-x)); }

struct ConvJob { const float* src; hf* dst; int K, N, mode; };
__device__ __forceinline__ ConvJob get_job(const Params& P, int l, int j) {
    hf* wb = (hf*)(P.ws + WS_W) + (size_t)l * E_LAYER;
    ConvJob r;
    switch (j) {
    case 0: r = {P.in[4] + (size_t)l * DM * DFF, wb + O_GU1, DM, DFF, 1}; break;
    case 1: r = {P.in[5] + (size_t)l * DM * DFF, wb + O_GU1, DM, DFF, 2}; break;
    case 2: r = {P.in[6] + (size_t)l * DFF * DM, wb + O_DN1, DFF, DM, 0}; break;
    case 3: r = {P.in[8] + (size_t)l * DM * PW, wb + O_WIN, DM, PW, 0}; break;
    case 4: r = {P.in[19] + (size_t)l * DM * DM, wb + O_WOUT, DM, DM, 0}; break;
    case 5: r = {P.in[22] + (size_t)l * DM * 512, wb + O_WQ, DM, 512, 0}; break;
    case 6: r = {P.in[23] + (size_t)l * DM * 1024, wb + O_WKV, DM, 1024, 0}; break;
    case 7: r = {P.in[26] + (size_t)l * 512 * DM, wb + O_WO, 512, DM, 0}; break;
    case 8: r = {P.in[28] + (size_t)l * DM * DFF, wb + O_GU2, DM, DFF, 1}; break;
    case 9: r = {P.in[29] + (size_t)l * DM * DFF, wb + O_GU2, DM, DFF, 2}; break;
    default: r = {P.in[30] + (size_t)l * DFF * DM, wb + O_DN2, DFF, DM, 0}; break;
    }
    return r;
}
__device__ void convert_weights(const Params& P, LAS unsigned char* lds, int bid, int nb) {
    const int tid = otid();
    constexpr int NT[11] = {2816, 2816, 2816, 2816, 1024, 256, 512, 256, 2816, 2816, 2816};
    constexpr int PER_LAYER = 21760;
    LAS hf* T = (LAS hf*)lds;
    for (int idx = bid; idx < 2 * PER_LAYER; idx += nb) {
        const int l = idx / PER_LAYER; int r = idx % PER_LAYER; int j = 0;
#pragma unroll
        for (int q = 0; q < 10; ++q) { if (j == q && r >= NT[q]) { r -= NT[q]; j = q + 1; } }
        const ConvJob jb = get_job(P, l, j);
        const int ntn = jb.N / 64, tn = r % ntn, tk = r / ntn, n0 = tn * 64, k0 = tk * 64;
        const int kr = tid >> 4, n4 = (tid & 15) * 4;
#pragma unroll
        for (int ps = 0; ps < 2; ++ps) { const int k = kr + 32 * ps; const f32x4 v = *(const f32x4*)(jb.src + (size_t)(k0 + k) * jb.N + n0 + n4);
#pragma unroll
            for (int e = 0; e < 4; ++e) T[(n4 + e) * 72 + k] = (hf)v[e]; }
        __syncthreads();
        { const int n = tid >> 3, k8 = tid & 7; const h8 w = *(const LAS h8*)(T + n * 72 + k8 * 8); const int gn = n0 + n;
          const int row = jb.mode == 0 ? gn : ((gn >> 7) * 256 + (gn & 127) + (jb.mode == 2 ? 128 : 0));
          *(h8*)(jb.dst + (size_t)row * jb.K + k0 + k8 * 8) = w; }
        __syncthreads();
    }
}

__device__ void norm_rows(const float* __restrict__ src, const float* __restrict__ g, hf* __restrict__ dst, int nrows, int bid, int nb) {
    const int tid = otid(), wid = tid >> 6, lane = tid & 63;
    for (int row = bid * 8 + wid; row < nrows; row += nb * 8) {
        const float* rp = src + (size_t)row * DM; f32x4 v[8]; float ss = 0.f;
#pragma unroll
        for (int e = 0; e < 8; ++e) { v[e] = *(const f32x4*)(rp + e * 256 + lane * 4); ss += v[e][0] * v[e][0] + v[e][1] * v[e][1] + v[e][2] * v[e][2] + v[e][3] * v[e][3]; }
        ss = wave_sum(ss); const float r = rsqrtf(ss * (1.0f / DM) + 1e-6f);
#pragma unroll
        for (int e = 0; e < 8; ++e) { const f32x4 gg = *(const f32x4*)(g + e * 256 + lane * 4); h4 w;
#pragma unroll
            for (int j = 0; j < 4; ++j) w[j] = (hf)(v[e][j] * r * gg[j]);
            *(h4*)(dst + (size_t)row * DM + e * 256 + lane * 4) = w; }
    }
}

__device__ void memkv_post(const Params& P, int bid, int nb) {
    const int tid = otid(), wid = tid >> 6, lane = tid & 63;
    const float* KV = (const float*)(P.ws + WS_MEMKV); hf* MK = (hf*)(P.ws + WS_MEMK); hf* MVT = (hf*)(P.ws + WS_MEMVT);
    for (int row = bid * 8 + wid; row < 2048; row += nb * 8) {
        const int l = row >> 10, b = (row >> 8) & 3, m = row & 255; const float* rp = KV + (size_t)row * 1024;
        const float* kn = P.in[25] + l * 128;
#pragma unroll
        for (int c = 0; c < 2; ++c) {
            const f32x4 v = *(const f32x4*)(rp + c * 256 + lane * 4); float ss = v[0] * v[0] + v[1] * v[1] + v[2] * v[2] + v[3] * v[3];
#pragma unroll
            for (int o = 16; o >= 1; o >>= 1) ss += __shfl_xor(ss, o);
            const float r = rsqrtf(ss * (1.0f / 128) + 1e-6f); const int h = c * 2 + (lane >> 5), d = (lane & 31) * 4; const f32x4 gg = *(const f32x4*)(kn + d); h4 w;
#pragma unroll
            for (int j = 0; j < 4; ++j) w[j] = (hf)(v[j] * r * gg[j]);
            *(h4*)(MK + ((size_t)((l * 4 + b) * 4 + h) * 256 + m) * 128 + d) = w;
        }
#pragma unroll
        for (int c = 0; c < 2; ++c) {
            const f32x4 v = *(const f32x4*)(rp + 512 + c * 256 + lane * 4); const int h = c * 2 + (lane >> 5), d = (lane & 31) * 4;
#pragma unroll
            for (int j = 0; j < 4; ++j) MVT[((size_t)((l * 4 + b) * 4 + h) * 128 + d + j) * 256 + m] = (hf)v[j];
        }
    }
}

__device__ void post_proj(const Params& P, int l, LAS unsigned char* lds, int bid, int nb) {
    const int tid = otid(), wid = tid >> 6, lane = tid & 63;
    const float* PROJ = (const float*)(P.ws + WS_BIG); float* U = (float*)(P.ws + WS_U);
    hf* MQ = (hf*)(P.ws + WS_MQ); hf* MK = (hf*)(P.ws + WS_MK); hf* MVT = (hf*)(P.ws + WS_MVT);
    hf* DQ = (hf*)(P.ws + WS_DQ); hf* DK = (hf*)(P.ws + WS_DK); hf* DVT = (hf*)(P.ws + WS_DVT); float* KPART = (float*)(P.ws + WS_KPART);
    const float* gmq = P.in[13] + l * 128; const float* gmk = P.in[14] + l * 128; const float* gdq = P.in[15] + l * 64; const float* gdk = P.in[16] + l * 64;
    LAS hf* T = (LAS hf*)lds;
    LAS float* KR = (LAS float*)(lds + 122880);
    const float sc_m = 0.08838834764831845f * LOG2E, sc_d = 0.125f * LOG2E;
    for (int item = bid; item < MT / 32; item += nb) {
        const int b = item >> 6, s0 = (item & 63) * 32;
        f32x4 ksum[3];
#pragma unroll
        for (int c = 0; c < 3; ++c) ksum[c] = (f32x4){0.f, 0.f, 0.f, 0.f};
        for (int it = 0; it < 4; ++it) {
            const int tl = wid * 4 + it, s = s0 + tl; const size_t tok = (size_t)b * SQ + s; const float* rp = PROJ + tok * PW;
#pragma unroll
            for (int c = 0; c < 2; ++c) { const f32x4 a = *(const f32x4*)(rp + c * 256 + lane * 4), gg = *(const f32x4*)(rp + 512 + c * 256 + lane * 4); f32x4 u;
#pragma unroll
                for (int j = 0; j < 4; ++j) u[j] = a[j] * sigmoidf_(gg[j]);
                *(f32x4*)(U + tok * 512 + c * 256 + lane * 4) = u; }
#pragma unroll
            for (int c = 0; c < 3; ++c) {
                const int h = c * 2 + (lane >> 5), d = (lane & 31) * 4;
                { const f32x4 v = *(const f32x4*)(rp + 1024 + c * 256 + lane * 4); float ss = v[0] * v[0] + v[1] * v[1] + v[2] * v[2] + v[3] * v[3];
#pragma unroll
                  for (int o = 16; o >= 1; o >>= 1) ss += __shfl_xor(ss, o);
                  const float r = rsqrtf(ss * (1.0f / 128) + 1e-6f) * sc_m; const f32x4 gg = *(const f32x4*)(gmq + d); h4 w;
#pragma unroll
                  for (int j = 0; j < 4; ++j) w[j] = (hf)(v[j] * r * gg[j]);
                  *(h4*)(MQ + ((size_t)(b * 6 + h) * SQ + s) * 128 + d) = w; }
                { const f32x4 v = *(const f32x4*)(rp + 1792 + c * 256 + lane * 4); float ss = v[0] * v[0] + v[1] * v[1] + v[2] * v[2] + v[3] * v[3];
#pragma unroll
                  for (int o = 16; o >= 1; o >>= 1) ss += __shfl_xor(ss, o);
                  const float r = rsqrtf(ss * (1.0f / 128) + 1e-6f); const f32x4 gg = *(const f32x4*)(gmk + d); h4 w;
#pragma unroll
                  for (int j = 0; j < 4; ++j) { const float kn = v[j] * r * gg[j]; w[j] = (hf)kn; ksum[c][j] += kn; }
                  *(h4*)(MK + ((size_t)(b * 6 + h) * SQ + s) * 128 + d) = w; }
                { const f32x4 v = *(const f32x4*)(rp + 2560 + c * 256 + lane * 4);
#pragma unroll
                  for (int j = 0; j < 4; ++j) T[(c * 256 + lane * 4 + j) * 40 + tl] = (hf)v[j]; }
            }
#pragma unroll
            for (int c = 0; c < 3; ++c) {
                const int hc = c * 4 + (lane >> 4), d = (lane & 15) * 4;
                { const f32x4 v = *(const f32x4*)(rp + 3328 + c * 256 + lane * 4); float ss = v[0] * v[0] + v[1] * v[1] + v[2] * v[2] + v[3] * v[3];
#pragma unroll
                  for (int o = 8; o >= 1; o >>= 1) ss += __shfl_xor(ss, o);
                  const float r = rsqrtf(ss * (1.0f / 64) + 1e-6f) * sc_d; const f32x4 gg = *(const f32x4*)(gdq + d); h4 w;
#pragma unroll
                  for (int j = 0; j < 4; ++j) w[j] = (hf)(v[j] * r * gg[j]);
                  *(h4*)(DQ + ((size_t)(b * 12 + hc) * SQ + s) * 64 + d) = w; }
                { const f32x4 v = *(const f32x4*)(rp + 4096 + c * 256 + lane * 4); float ss = v[0] * v[0] + v[1] * v[1] + v[2] * v[2] + v[3] * v[3];
#pragma unroll
                  for (int o = 8; o >= 1; o >>= 1) ss += __shfl_xor(ss, o);
                  const float r = rsqrtf(ss * (1.0f / 64) + 1e-6f); const f32x4 gg = *(const f32x4*)(gdk + d); h4 w;
#pragma unroll
                  for (int j = 0; j < 4; ++j) w[j] = (hf)(v[j] * r * gg[j]);
                  *(h4*)(DK + ((size_t)(b * 12 + hc) * SQ + s) * 64 + d) = w; }
                { const f32x4 v = *(const f32x4*)(rp + 4864 + c * 256 + lane * 4);
#pragma unroll
                  for (int j = 0; j < 4; ++j) T[(768 + c * 256 + lane * 4 + j) * 40 + tl] = (hf)v[j]; }
            }
        }
#pragma unroll
        for (int c = 0; c < 3; ++c) *(LAS f32x4*)(KR + wid * 768 + c * 256 + lane * 4) = ksum[c];
        __syncthreads();
        for (int e = tid; e < 768; e += 512) { float a = 0.f;
#pragma unroll
            for (int w = 0; w < 8; ++w) a += KR[w * 768 + e];
            KPART[(size_t)item * 768 + e] = a; }
        for (int rr = tid; rr < 1536; rr += 512) {
            const int v2 = rr >= 768, r7 = rr - v2 * 768, h = r7 >> 7, d = r7 & 127; hf* dstp = (v2 ? DVT : MVT) + ((size_t)(b * 6 + h) * 128 + d) * SQ + s0;
#pragma unroll
            for (int q = 0; q < 4; ++q) *(h8*)(dstp + q * 8) = *(const LAS h8*)(T + rr * 40 + q * 8);
        }
        __syncthreads();
    }
}

__device__ __forceinline__ void conv_item(const Params& P, int l, int item) {
    const int tid = otid(), wid = tid >> 6, lane = tid & 63;
    const float* U = (const float*)(P.ws + WS_U); hf* Y = (hf*)(P.ws + WS_YCAT);
    const float* cw = P.in[9] + (size_t)l * CONVW * CONVC; const float* cb = P.in[10] + l * CONVC; const float* lg = P.in[11] + l * CONVC; const float* lb = P.in[12] + l * CONVC;
    const int b = item >> 7, s0 = (item & 127) * 16; const int c0 = lane * 8;
    for (int it = 0; it < 2; ++it) {
        const int s = s0 + wid * 2 + it; float acc[8];
        { const f32x4 b0 = *(const f32x4*)(cb + c0), b1 = *(const f32x4*)(cb + c0 + 4);
#pragma unroll
          for (int j = 0; j < 4; ++j) { acc[j] = b0[j]; acc[4 + j] = b1[j]; } }
        const int j0 = s >= 30 ? 0 : 30 - s;
        for (int j = j0; j < CONVW; ++j) {
            const float* up = U + ((size_t)b * SQ + (s - 30 + j)) * 512 + c0; const float* wp = cw + j * CONVC + c0;
            const f32x4 u0 = *(const f32x4*)up, u1 = *(const f32x4*)(up + 4), w0 = *(const f32x4*)wp, w1 = *(const f32x4*)(wp + 4);
#pragma unroll
            for (int e = 0; e < 4; ++e) { acc[e] += u0[e] * w0[e]; acc[4 + e] += u1[e] * w1[e]; }
        }
        float sm = 0.f;
#pragma unroll
        for (int e = 0; e < 8; ++e) sm += acc[e];
        const float mu = wave_sum(sm) * (1.0f / 512); float q = 0.f;
#pragma unroll
        for (int e = 0; e < 8; ++e) { const float dd = acc[e] - mu; q += dd * dd; }
        const float rstd = rsqrtf(wave_sum(q) * (1.0f / 512) + 1e-5f);
        const f32x4 g0 = *(const f32x4*)(lg + c0), g1 = *(const f32x4*)(lg + c0 + 4), bb0 = *(const f32x4*)(lb + c0), bb1 = *(const f32x4*)(lb + c0 + 4); h8 w;
#pragma unroll
        for (int e = 0; e < 8; ++e) { const float y = (acc[e] - mu) * rstd * (e < 4 ? g0[e] : g1[e - 4]) + (e < 4 ? bb0[e] : bb1[e - 4]); w[e] = (hf)(y * sigmoidf_(y)); }
        *(h8*)(Y + ((size_t)b * SQ + s) * DM + c0) = w;
    }
}

constexpr int A_STG = 0, A_STG_BYTES = 35840, A_QS = 71680, A_LUT = 106496, A_TK0 = 107520, A_SELM = 107776, A_KM = 108288, A_GATE = 111872, A_MISC = 115968;
constexpr int VSTR = 144;
template <int DQK, bool CAUSAL, bool BIAS, bool QLDS>
__device__ __forceinline__ void flash_core(LAS unsigned char* lds, const hf* Qb, const hf* Kb, const hf* VTb, int vts, int q0, int ntiles, unsigned selmask, f32x4 (&O)[8], float& lsum) {
    constexpr int KSTR = DQK * 2 + 16, KT_BYTES = 64 * KSTR, NKK = DQK / 32, KCH = DQK / 64;
    int tid = threadIdx.x; asm volatile("" : "+v"(tid));
    const int wid = __builtin_amdgcn_readfirstlane(tid >> 6), lane = tid & 63, i = lane & 15, g = lane >> 4;
    const int q0w = q0 + wid * 16, qpos = q0w + i;
    LAS const int* tk0 = (LAS const int*)(lds + A_TK0); LAS const float* lut = (LAS const float*)(lds + A_LUT);
    h8 qf[NKK];
#pragma unroll
    for (int kk = 0; kk < NKK; ++kk) {
        if (QLDS) qf[kk] = *(const LAS h8*)(lds + A_QS + (wid * 16 + i) * 272 + kk * 64 + g * 16);
        else qf[kk] = *(const h8*)(Qb + (size_t)qpos * DQK + kk * 32 + g * 8);
    }
#pragma unroll
    for (int dt = 0; dt < 8; ++dt) O[dt] = (f32x4){0.f, 0.f, 0.f, 0.f};
    float mrow = NEGV; lsum = 0.f;
    h8 kreg[KCH], vreg[2];
#define FA_LOADG(k0_) do { _Pragma("unroll") for (int e = 0; e < KCH; ++e) { const int c = tid + 512 * e, row = c / (DQK / 8), c8 = c % (DQK / 8); kreg[e] = *(const h8*)(Kb + (size_t)((k0_) + row) * DQK + c8 * 8); } \
        _Pragma("unroll") for (int e = 0; e < 2; ++e) { const int c = tid + 512 * e, d = c >> 3, k8 = c & 7; vreg[e] = *(const h8*)(VTb + (size_t)d * vts + (k0_) + k8 * 8); } } while (0)
#define FA_STORE(buf_) do { LAS unsigned char* sb = lds + A_STG + (buf_) * A_STG_BYTES; \
        _Pragma("unroll") for (int e = 0; e < KCH; ++e) { const int c = tid + 512 * e, row = c / (DQK / 8), c8 = c % (DQK / 8); const int p = (row & 32) | ((row & 4) << 2) | ((row & 24) >> 1) | (row & 3); *(LAS h8*)(sb + p * KSTR + c8 * 16) = kreg[e]; } \
        _Pragma("unroll") for (int e = 0; e < 2; ++e) { const int c = tid + 512 * e, d = c >> 3, k8 = c & 7; *(LAS h8*)(sb + KT_BYTES + d * VSTR + k8 * 16) = vreg[e]; } } while (0)
    { const int k00 = tk0[0]; FA_LOADG(k00); FA_STORE(0); }
    __syncthreads();
    for (int t = 0; t < ntiles; ++t) {
        const int k0 = tk0[t];
        const bool more = (t + 1 < ntiles);
        if (more) { const int k0n = tk0[t + 1]; FA_LOADG(k0n); }
        const bool selok = (selmask >> (k0 >> 8)) & 1u;
        const bool active = (!CAUSAL || k0 <= q0w + 15) && (__ballot(selok) != 0ull);
        if (active) {
            LAS const unsigned char* kb = lds + A_STG + (t & 1) * A_STG_BYTES; LAS const unsigned char* vb = kb + KT_BYTES;
            f32x4 sa[4];
#pragma unroll
            for (int st = 0; st < 4; ++st) { sa[st] = (f32x4){0.f, 0.f, 0.f, 0.f};
#pragma unroll
                for (int kk = 0; kk < NKK; ++kk) { const h8 kf = *(const LAS h8*)(kb + (16 * st + i) * KSTR + g * 16 + kk * 64); sa[st] = __builtin_amdgcn_mfma_f32_16x16x32_f16(kf, qf[kk], sa[st], 0, 0, 0); } }
            if (BIAS) {
                const bool far = (k0 + 63 + 128 <= q0w);
                if (far) { const float bc = lut[128];
#pragma unroll
                    for (int st = 0; st < 4; ++st)
#pragma unroll
                        for (int r = 0; r < 4; ++r) sa[st][r] += bc;
                } else {
#pragma unroll
                    for (int st = 0; st < 4; ++st)
#pragma unroll
                        for (int r = 0; r < 4; ++r) { const int key = k0 + 32 * (st >> 1) + 8 * g + 4 * (st & 1) + r; const int dist = qpos - key; const int dc = dist < 0 ? 0 : (dist > 128 ? 128 : dist);
                            sa[st][r] = dist >= 0 ? sa[st][r] + lut[dc] : NEGV; }
                }
            }
            if (!selok) {
#pragma unroll
                for (int st = 0; st < 4; ++st)
#pragma unroll
                    for (int r = 0; r < 4; ++r) sa[st][r] = NEGV;
            }
            float mx = NEGV;
#pragma unroll
            for (int st = 0; st < 4; ++st)
#pragma unroll
                for (int r = 0; r < 4; ++r) mx = fmaxf(mx, sa[st][r]);
            mx = fmaxf(mx, __shfl_xor(mx, 16)); mx = fmaxf(mx, __shfl_xor(mx, 32));
            const float mnew = fmaxf(mrow, mx), alpha = __builtin_amdgcn_exp2f(mrow - mnew); mrow = mnew;
            float ps = 0.f; h8 pf[2];
#pragma unroll
            for (int st = 0; st < 4; ++st)
#pragma unroll
                for (int r = 0; r < 4; ++r) { const float p = __builtin_amdgcn_exp2f(sa[st][r] - mnew); ps += p; pf[st >> 1][(st & 1) * 4 + r] = (hf)p; }
            lsum = lsum * alpha + ps;
#pragma unroll
            for (int dt = 0; dt < 8; ++dt) { O[dt] *= alpha;
#pragma unroll
                for (int s2 = 0; s2 < 2; ++s2) { const h8 vf = *(const LAS h8*)(vb + (16 * dt + i) * VSTR + (32 * s2 + 8 * g) * 2); O[dt] = __builtin_amdgcn_mfma_f32_16x16x32_f16(vf, pf[s2], O[dt], 0, 0, 0); } }
        }
        if (more) FA_STORE((t + 1) & 1);
        __syncthreads();
    }
#undef FA_LOADG
#undef FA_STORE
}
__device__ __forceinline__ float row_total(float l) { l += __shfl_xor(l, 16); l += __shfl_xor(l, 32); return l; }

__device__ __forceinline__ int t5_bucket(int dist) {
    if (dist < 16) return dist;
    const float lr = logf((float)dist / 16.0f) / 2.0794415416798357f;
    const int v = 16 + (int)(lr * 16.0f);
    return v < 31 ? v : 31;
}
__device__ __forceinline__ void fill_lut(LAS unsigned char* lds, const float* rel_bias, int hcol) {
    LAS float* lut = (LAS float*)(lds + A_LUT);
    for (int d = otid(); d <= 128; d += 512) lut[d] = rel_bias[t5_bucket(d) * 12 + hcol] * LOG2E;
}

__device__ __forceinline__ void diff_item(const Params& P, int l, LAS unsigned char* lds, int bh, int qt) {
    const int tid = otid(), wid = __builtin_amdgcn_readfirstlane(tid >> 6), lane = tid & 63, i = lane & 15, g = lane >> 4;
    const int b = bh / 6, h = bh % 6, q0 = qt * 128;
    const hf* DQ = (const hf*)(P.ws + WS_DQ); const hf* DK = (const hf*)(P.ws + WS_DK); const hf* DVT = (const hf*)(P.ws + WS_DVT); hf* Y = (hf*)(P.ws + WS_YCAT);
    fill_lut(lds, P.in[2], 6 + h);
    const int ntiles = (q0 + 128) / 64;
    LAS int* tk0 = (LAS int*)(lds + A_TK0);
    if (tid < ntiles) tk0[tid] = tid * 64;
    const float* lp = P.in[17] + l * 256;
    const float s1 = wave_sum(lp[lane] * lp[64 + lane]), s2 = wave_sum(lp[128 + lane] * lp[192 + lane]);
    const float lam_init = 0.8f - 0.6f * expf(-0.3f * (float)l);
    const float lam = expf(s1) - expf(s2) + lam_init;
    __syncthreads();
    const hf* VT = DVT + (size_t)(b * 6 + h) * 128 * SQ;
    f32x4 O1[8], O2[8]; float l1, l2;
    flash_core<64, true, true, false>(lds, DQ + (size_t)((b * 6 + h) * 2 + 0) * SQ * 64, DK + (size_t)((b * 6 + h) * 2 + 0) * SQ * 64, VT, SQ, q0, ntiles, 0xffffffffu, O1, l1);
    { const float inv = 1.0f / row_total(l1);
#pragma unroll
      for (int dt = 0; dt < 8; ++dt) O1[dt] *= inv; }
    flash_core<64, true, true, false>(lds, DQ + (size_t)((b * 6 + h) * 2 + 1) * SQ * 64, DK + (size_t)((b * 6 + h) * 2 + 1) * SQ * 64, VT, SQ, q0, ntiles, 0xffffffffu, O2, l2);
    const float inv2 = lam / row_total(l2); float ss = 0.f;
#pragma unroll
    for (int dt = 0; dt < 8; ++dt) { O1[dt] -= O2[dt] * inv2; ss += O1[dt][0] * O1[dt][0] + O1[dt][1] * O1[dt][1] + O1[dt][2] * O1[dt][2] + O1[dt][3] * O1[dt][3]; }
    ss = row_total(ss);
    const float r = rsqrtf(ss * (1.0f / 128) + 1e-6f) * (1.0f - lam_init);
    const float* sg = P.in[18] + l * 128;
    hf* yp = Y + ((size_t)b * SQ + q0 + wid * 16 + i) * DM + 1280 + h * 128;
#pragma unroll
    for (int dt = 0; dt < 8; ++dt) { const f32x4 gg = *(const f32x4*)(sg + dt * 16 + g * 4); h4 w;
#pragma unroll
        for (int j = 0; j < 4; ++j) w[j] = (hf)(O1[dt][j] * r * gg[j]);
        *(h4*)(yp + dt * 16 + g * 4) = w; }
}

__device__ __forceinline__ void moba_item(const Params& P, int l, LAS unsigned char* lds, int bh, int qt) {
    const int tid = otid(), wid = __builtin_amdgcn_readfirstlane(tid >> 6), lane = tid & 63, i = lane & 15, g = lane >> 4;
    const int b = bh / 6, h = bh % 6, q0 = qt * 128, cur = q0 >> 8;
    const hf* MQ = (const hf*)(P.ws + WS_MQ) + (size_t)(b * 6 + h) * SQ * 128; const hf* MK = (const hf*)(P.ws + WS_MK) + (size_t)(b * 6 + h) * SQ * 128;
    const hf* MVT = (const hf*)(P.ws + WS_MVT) + (size_t)(b * 6 + h) * 128 * SQ; const float* KPART = (const float*)(P.ws + WS_KPART); hf* Y = (hf*)(P.ws + WS_YCAT);
    fill_lut(lds, P.in[2], h);
    LAS int* tk0 = (LAS int*)(lds + A_TK0); LAS unsigned* selm = (LAS unsigned*)(lds + A_SELM); LAS float* KM = (LAS float*)(lds + A_KM); LAS float* GT = (LAS float*)(lds + A_GATE);
    LAS unsigned* misc = (LAS unsigned*)(lds + A_MISC);
    for (int e = tid; e < cur * 128; e += 512) { const int j = e >> 7, d = e & 127; float a = 0.f;
#pragma unroll
        for (int c = 0; c < 8; ++c) a += KPART[((size_t)b * 64 + j * 8 + c) * 768 + h * 128 + d];
        KM[e] = a * (1.0f / 256); }
    if (tid == 0) misc[1] = 0u;
    __syncthreads();
    {
        const int r = tid >> 2, jj = tid & 3; const hf* qp = MQ + (size_t)(q0 + r) * 128; float g0 = 0.f, g1 = 0.f;
        if (jj < cur) {
            for (int d8 = 0; d8 < 16; ++d8) { const h8 qv = *(const h8*)(qp + d8 * 8);
#pragma unroll
                for (int e = 0; e < 8; ++e) { const float qx = (float)qv[e]; g0 += qx * KM[jj * 128 + d8 * 8 + e]; if (jj + 4 < cur) g1 += qx * KM[(jj + 4) * 128 + d8 * 8 + e]; } }
        }
        GT[r * 8 + jj] = g0; GT[r * 8 + jj + 4] = g1;
    }
    __syncthreads();
    if (tid < 128) {
        unsigned m = 0u;
        if (cur <= 3) m = (1u << cur) - 1u;
        else {
            for (int k = 0; k < 3; ++k) { float best = -3.0e38f; int bi = 0;
                for (int j = 0; j < cur; ++j) { const float v = GT[tid * 8 + j]; if (!((m >> j) & 1u) && v > best) { best = v; bi = j; } }
                m |= 1u << bi; }
        }
        selm[tid] = m | (1u << cur);
        atomicOr((unsigned*)&misc[1], m);
    }
    __syncthreads();
    const unsigned vis = misc[1];
    int ntiles = 0;
    {
        const int own_t = (q0 + 128 - cur * 256) / 64;
        if (tid == 0) { int n = 0; for (int t = 0; t < own_t; ++t) tk0[n++] = cur * 256 + t * 64; for (int j = 0; j < cur; ++j) if ((vis >> j) & 1u) for (int t = 0; t < 4; ++t) tk0[n++] = j * 256 + t * 64; }
        ntiles = own_t + 4 * __popc(vis);
    }
    __syncthreads();
    const unsigned mysel = selm[wid * 16 + i];
    f32x4 O[8]; float ls;
    flash_core<128, true, true, false>(lds, MQ, MK, MVT, SQ, q0, ntiles, mysel, O, ls);
    const float inv = 1.0f / row_total(ls);
    hf* yp = Y + ((size_t)b * SQ + q0 + wid * 16 + i) * DM + 512 + h * 128;
#pragma unroll
    for (int dt = 0; dt < 8; ++dt) { h4 w;
#pragma unroll
        for (int j = 0; j < 4; ++j) w[j] = (hf)(O[dt][j] * inv);
        *(h4*)(yp + dt * 16 + g * 4) = w; }
}

__device__ __forceinline__ void mem_item(const Params& P, int l, LAS unsigned char* lds, int item) {
    const int tid = otid(), wid = __builtin_amdgcn_readfirstlane(tid >> 6), lane = tid & 63, i = lane & 15, g = lane >> 4;
    const int qt = item & 15, h = (item >> 4) & 3, b = item >> 6, q0 = qt * 128;
    const float* QF = (const float*)(P.ws + WS_BIG); hf* OM = (hf*)(P.ws + WS_OMEM);
    const hf* K = (const hf*)(P.ws + WS_MEMK) + (size_t)((l * 4 + b) * 4 + h) * 256 * 128; const hf* VT = (const hf*)(P.ws + WS_MEMVT) + (size_t)((l * 4 + b) * 4 + h) * 128 * 256;
    LAS int* tk0 = (LAS int*)(lds + A_TK0);
    if (tid < 4) tk0[tid] = tid * 64;
    { const int r = tid >> 2, qq = tid & 3; const float* qp = QF + ((size_t)b * SQ + q0 + r) * 512 + h * 128 + qq * 32; f32x4 v[8]; float ss = 0.f;
#pragma unroll
      for (int e = 0; e < 8; ++e) { v[e] = *(const f32x4*)(qp + e * 4); ss += v[e][0] * v[e][0] + v[e][1] * v[e][1] + v[e][2] * v[e][2] + v[e][3] * v[e][3]; }
      ss += __shfl_xor(ss, 1); ss += __shfl_xor(ss, 2);
      const float rr = rsqrtf(ss * (1.0f / 128) + 1e-6f) * (0.08838834764831845f * LOG2E); const float* gq = P.in[24] + l * 128 + qq * 32;
#pragma unroll
      for (int e = 0; e < 8; ++e) { const f32x4 gg = *(const f32x4*)(gq + e * 4); h4 w;
#pragma unroll
          for (int j = 0; j < 4; ++j) w[j] = (hf)(v[e][j] * rr * gg[j]);
          *(LAS h4*)(lds + A_QS + r * 272 + (qq * 32 + e * 4) * 2) = w; } }
    __syncthreads();
    f32x4 O[8]; float ls;
    flash_core<128, false, false, true>(lds, nullptr, K, VT, 256, q0, 4, 0xffffffffu, O, ls);
    const float inv = 1.0f / row_total(ls);
    hf* yp = OM + ((size_t)b * SQ + q0 + wid * 16 + i) * 512 + h * 128;
#pragma unroll
    for (int dt = 0; dt < 8; ++dt) { h4 w;
#pragma unroll
        for (int j = 0; j < 4; ++j) w[j] = (hf)(O[dt][j] * inv);
        *(h4*)(yp + dt * 16 + g * 4) = w; }
}

__device__ __forceinline__ int next_item(LAS unsigned char* lds, int* cnt) {
    LAS int* misc = (LAS int*)(lds + A_MISC);
    __syncthreads();
    if (threadIdx.x == 0) misc[0] = atomicAdd(cnt, 1);
    __syncthreads();
    return misc[0];
}

__global__ void __launch_bounds__(512, 2) fwd_mega(Params P) {
    extern __shared__ __attribute__((aligned(16))) unsigned char smem[];
    LAS unsigned char* lds = (LAS unsigned char*)smem;
    cg::grid_group grid = cg::this_grid();
    const int bid = blockIdx.x, nb = gridDim.x;
    const int lo = P.ph_lo, hi = P.ph_hi;
    int ph = 0;
#define PHASE_BEGIN if (ph >= lo && ph < hi) {
#define PHASE_END(SYNC) if ((SYNC) && ph + 1 < hi) grid.sync(); } ++ph;
    hf* H = (hf*)(P.ws + WS_H); hf* HID = (hf*)(P.ws + WS_BIG); float* PROJ = (float*)(P.ws + WS_BIG); hf* YC = (hf*)(P.ws + WS_YCAT); hf* OM = (hf*)(P.ws + WS_OMEM);
    int* CNT = (int*)(P.ws + WS_CNT);
    float* X = P.out;

    PHASE_BEGIN
        if (bid == 0 && threadIdx.x < 64) CNT[threadIdx.x] = 0;
        convert_weights(P, lds, bid, nb);
        for (int l = 0; l < NL; ++l) norm_rows(P.in[1], P.in[21] + l * DM, (hf*)(P.ws + WS_MEMH) + (size_t)l * 1024 * DM, 1024, bid, nb);
        norm_rows(P.in[0], P.in[3], H, MT, bid, nb);
    PHASE_END(true)

    for (int l = 0; l < NL; ++l) {
        const hf* W = (const hf*)(P.ws + WS_W) + (size_t)l * E_LAYER;
        const float* xin = (l == 0) ? P.in[0] : X;
        PHASE_BEGIN
            { pg8::Gemm g{H, W + O_GU1, MT, 2 * DFF, DM}; pg8::StaticOrder S; S.init(MT, 2 * DFF, nb, bid); pg8::EpiSwiGLU E{HID, DFF}; pg8::gemm_phase(lds, g, S, E); }
            if (l == 0) {
                for (int l2 = 0; l2 < NL; ++l2) { pg8::Gemm g{(const hf*)(P.ws + WS_MEMH) + (size_t)l2 * 1024 * DM, (const hf*)(P.ws + WS_W) + (size_t)l2 * E_LAYER + O_WKV, 1024, 1024, DM};
                    pg8::StaticOrder S; S.init(1024, 1024, nb, (bid + nb - 128 - 16 * l2) % nb); pg8::EpiF32 E{(float*)(P.ws + WS_MEMKV) + (size_t)l2 * 1024 * 1024, 1024}; pg8::gemm_phase(lds, g, S, E); }
            }
        PHASE_END(true)
        PHASE_BEGIN
            { pg8::Gemm g{HID, W + O_DN1, MT, DM, DFF}; pg8::StaticOrder S; S.init(MT, DM, nb, bid); pg8::EpiRes E{xin, X, DM, 0.5f}; pg8::gemm_phase(lds, g, S, E); }
        PHASE_END(true)
        PHASE_BEGIN
            norm_rows(X, P.in[7] + l * DM, H, MT, bid, nb);
            if (l == 0) memkv_post(P, bid, nb);
        PHASE_END(true)
        PHASE_BEGIN
            { pg8::Gemm g{H, W + O_WIN, MT, PW, DM}; pg8::StaticOrder S; S.init(MT, PW, nb, bid); pg8::EpiF32 E{PROJ, PW}; pg8::gemm_phase(lds, g, S, E); }
        PHASE_END(true)
        PHASE_BEGIN
            post_proj(P, l, lds, bid, nb);
        PHASE_END(true)
        PHASE_BEGIN
            for (;;) {
                const int it = next_item(lds, CNT + l * 4 + 0);
                if (it >= 768 + 512) break;
                if (it < 768) { const int rnd = it / 48, w = it % 48, qt = 15 - rnd; if (w < 24) diff_item(P, l, lds, w, qt); else moba_item(P, l, lds, w - 24, qt); }
                else conv_item(P, l, it - 768);
            }
        PHASE_END(true)
        PHASE_BEGIN
            { pg8::Gemm g{YC, W + O_WOUT, MT, DM, DM}; pg8::StaticOrder S; S.init(MT, DM, nb, bid); pg8::EpiRes E{X, X, DM, 1.0f}; pg8::gemm_phase(lds, g, S, E); }
        PHASE_END(true)
        PHASE_BEGIN
            norm_rows(X, P.in[20] + l * DM, H, MT, bid, nb);
        PHASE_END(true)
        PHASE_BEGIN
            { pg8::Gemm g{H, W + O_WQ, MT, 512, DM}; pg8::StaticOrder S; S.init(MT, 512, nb, bid); pg8::EpiF32 E{(float*)(P.ws + WS_BIG), 512}; pg8::gemm_phase(lds, g, S, E); }
        PHASE_END(true)
        PHASE_BEGIN
            for (;;) { const int it = next_item(lds, CNT + l * 4 + 1); if (it >= 256) break; mem_item(P, l, lds, it); }
        PHASE_END(true)
        PHASE_BEGIN
            { pg8::Gemm g{OM, W + O_WO, MT, DM, 512}; pg8::StaticOrder S; S.init(MT, DM, nb, bid); pg8::EpiRes E{X, X, DM, 1.0f}; pg8::gemm_phase(lds, g, S, E); }
        PHASE_END(true)
        PHASE_BEGIN
            norm_rows(X, P.in[27] + l * DM, H, MT, bid, nb);
        PHASE_END(true)
        PHASE_BEGIN
            { pg8::Gemm g{H, W + O_GU2, MT, 2 * DFF, DM}; pg8::StaticOrder S; S.init(MT, 2 * DFF, nb, bid); pg8::EpiSwiGLU E{HID, DFF}; pg8::gemm_phase(lds, g, S, E); }
        PHASE_END(true)
        PHASE_BEGIN
            { pg8::Gemm g{HID, W + O_DN2, MT, DM, DFF}; pg8::StaticOrder S; S.init(MT, DM, nb, bid); pg8::EpiRes E{X, X, DM, 0.5f}; pg8::gemm_phase(lds, g, S, E); }
        PHASE_END(true)
        if (l + 1 < NL) {
            PHASE_BEGIN
                norm_rows(X, P.in[3] + (l + 1) * DM, H, MT, bid, nb);
            PHASE_END(true)
        }
    }
}

extern "C" void kernel_launch(void* const* d_in, const int* in_sizes, int n_in, void* d_out, int out_size, void* d_ws, size_t ws_size, hipStream_t stream) {
    static int grid_blocks = 0;
    if (grid_blocks == 0) {
        if (n_in != 31 || out_size != MT * DM || ws_size < WS_END) { fprintf(stderr, "kernel_launch: unexpected shapes (n_in %d out %d ws %zu need %zu)\n", n_in, out_size, ws_size, (size_t)WS_END); grid_blocks = -1; return; }
        int dev = 0, cus = 0, per_cu = 0;
        hipGetDevice(&dev);
        hipDeviceGetAttribute(&cus, hipDeviceAttributeMultiprocessorCount, dev);
        if (hipFuncSetAttribute((const void*)fwd_mega, hipFuncAttributeMaxDynamicSharedMemorySize, LDS_BYTES) != hipSuccess) { fprintf(stderr, "hipFuncSetAttribute failed\n"); grid_blocks = -1; return; }
        hipOccupancyMaxActiveBlocksPerMultiprocessor(&per_cu, (const void*)fwd_mega, 512, LDS_BYTES);
        if (per_cu < 1) { fprintf(stderr, "occupancy query says %d blocks per CU\n", per_cu); per_cu = 1; }
        (void)hipGetLastError();
        grid_blocks = cus;
    }
    if (grid_blocks < 0) return;
    Params p{};
    for (int i = 0; i < 31; ++i) p.in[i] = (const float*)d_in[i];
    p.out = (float*)d_out; p.ws = (unsigned char*)d_ws; p.ph_lo = 0; p.ph_hi = 1000;
    void* args[] = {&p};
    hipError_t e = hipLaunchCooperativeKernel((const void*)fwd_mega, dim3(grid_blocks), dim3(512), args, LDS_BYTES, stream);
    if (e != hipSuccess) fprintf(stderr, "cooperative launch failed: %s (grid %d)\n", hipGetErrorString(e), grid_blocks);
}
```

```cpp
#include <hip/hip_runtime.h>
#include <hip/hip_cooperative_groups.h>
#include <cstdio>
namespace cg = cooperative_groups;

#define LAS __attribute__((address_space(3)))
typedef _Float16 hf;
typedef _Float16 h8 __attribute__((ext_vector_type(8)));
typedef _Float16 h4 __attribute__((ext_vector_type(4)));
typedef float f32x4 __attribute__((ext_vector_type(4)));

constexpr int DM = 2048, NB = 4, SQ = 2048, MT = NB * SQ, DFF = 5632, PW = 5632, NL = 2;
constexpr int CONVC = 512, CONVW = 31, MEML = 256;
constexpr float LOG2E = 1.4426950408889634f;
constexpr float NEGV = -1e30f;
constexpr int LDS_BYTES = 147456;

constexpr size_t E_GU = (size_t)2 * DFF * DM, E_DN = (size_t)DM * DFF, E_WIN = (size_t)PW * DM, E_WOUT = (size_t)DM * DM, E_WQ = (size_t)512 * DM, E_WKV = (size_t)1024 * DM, E_WO = (size_t)DM * 512;
constexpr size_t O_GU1 = 0, O_DN1 = O_GU1 + E_GU, O_WIN = O_DN1 + E_DN, O_WOUT = O_WIN + E_WIN, O_WQ = O_WOUT + E_WOUT, O_WKV = O_WQ + E_WQ, O_WO = O_WKV + E_WKV, O_GU2 = O_WO + E_WO, O_DN2 = O_GU2 + E_GU, E_LAYER = O_DN2 + E_DN;
constexpr size_t WS_W = 0;
constexpr size_t WS_H = WS_W + 2 * E_LAYER * 2;
constexpr size_t WS_BIG = WS_H + (size_t)MT * DM * 2;
constexpr size_t WS_U = WS_BIG + (size_t)MT * PW * 4;
constexpr size_t WS_MQ = WS_U + (size_t)MT * 512 * 4;
constexpr size_t WS_MK = WS_MQ + (size_t)MT * 768 * 2;
constexpr size_t WS_MVT = WS_MK + (size_t)MT * 768 * 2;
constexpr size_t WS_DQ = WS_MVT + (size_t)MT * 768 * 2;
constexpr size_t WS_DK = WS_DQ + (size_t)MT * 768 * 2;
constexpr size_t WS_DVT = WS_DK + (size_t)MT * 768 * 2;
constexpr size_t WS_YCAT = WS_DVT + (size_t)MT * 768 * 2;
constexpr size_t WS_KPART = WS_YCAT + (size_t)MT * DM * 2;
constexpr size_t WS_MEMH = WS_KPART + (size_t)4 * 64 * 768 * 4;
constexpr size_t WS_MEMKV = WS_MEMH + (size_t)2 * 1024 * DM * 2;
constexpr size_t WS_MEMK = WS_MEMKV + (size_t)2 * 1024 * 1024 * 4;
constexpr size_t WS_MEMVT = WS_MEMK + (size_t)2 * 1024 * 512 * 2;
constexpr size_t WS_OMEM = WS_MEMVT + (size_t)2 * 1024 * 512 * 2;
constexpr size_t WS_CNT = WS_OMEM + (size_t)MT * 512 * 2;
constexpr size_t WS_PSS = WS_CNT + 256;
constexpr size_t WS_END = WS_PSS + (size_t)MT * 32 * 4;

struct Params {
    const float* in[31];
    float* out;
    unsigned char* ws;
    int ph_lo, ph_hi;
};

__device__ __forceinline__ int otid() { int t = threadIdx.x; asm volatile("" : "+v"(t)); return t; }
namespace pg8 {
constexpr int BM = 256, BK = 64, HALF = 128, HTB = HALF * BK * 2, STAGE_BYTES = 8 * HTB, NXCD = 8, WGM = 8;
__host__ __device__ __forceinline__ int lds_byte(int r, int c) { const int st = (r >> 4) * 2 + (c >> 5), rr = r & 15, cc = c & 31, ob = rr * 64 + cc * 2; return st * 1024 + (ob ^ (((ob >> 9) & 1) << 5)); }
__host__ __device__ __forceinline__ void stage_rc(int b, int& R, int& C) { const int st = b / 1024, sb = b % 1024, swz = sb ^ (((sb >> 9) & 1) << 5); R = (st >> 1) * 16 + swz / 64; C = (st & 1) * 32 + (swz % 64) / 2; }
__host__ __device__ __forceinline__ int perm32(int rho) { const int n = rho >> 4, i = rho & 15; return 8 * (i >> 2) + 4 * n + (i & 3); }
struct Unit { int pm, pn; };
struct Gemm { const hf* A; const hf* Bt; int M, N, K; };
struct StaticOrder {
    int nM, nN, nwg, G, c;
    __device__ __forceinline__ void init(int M, int N, int G_, int c_) { nM = M / BM; nN = N / BM; nwg = nM * nN; G = G_; c = c_; }
    __device__ __forceinline__ bool next(int i, Unit& u) const {
        const long L = (long)i * G + c; if (L >= nwg) return false;
        int wgid = (int)L; { const int q = nwg / NXCD, r = nwg % NXCD, xcd = wgid % NXCD, off = wgid / NXCD; wgid = (xcd < r ? xcd * (q + 1) : r * (q + 1) + (xcd - r) * q) + off; }
        const int nig = WGM * nN, gid = wgid / nig, fm = gid * WGM, gsz = (nM - fm) < WGM ? (nM - fm) : WGM;
        u.pm = fm + ((wgid % nig) % gsz); u.pn = (wgid % nig) / gsz; return true;
    }
};
struct EpiF32 {
    static constexpr bool PERM = false;
    float* C; int ldc; LAS const float* rs;
    __device__ __forceinline__ void operator()(const f32x4 (&acc)[2][2][4][2], const Unit& u, int ui, int wr, int wc, int fr, int fq) const {
        const int row0 = u.pm * BM + wr * 64 + fr, col0 = u.pn * BM + wc * 32 + 4 * fq;
#pragma unroll
        for (int ai = 0; ai < 2; ++ai)
#pragma unroll
            for (int m = 0; m < 4; ++m) { float* rowp = C + (size_t)(row0 + ai * HALF + m * 16) * ldc + col0; const float sc = rs ? rs[ui * 256 + wr * 64 + fr + ai * HALF + m * 16] : 1.0f;
#pragma unroll
                for (int bj = 0; bj < 2; ++bj)
#pragma unroll
                    for (int n = 0; n < 2; ++n) *(f32x4*)(rowp + bj * HALF + n * 16) = acc[ai][bj][m][n] * sc; }
    }
};
struct EpiRes {
    static constexpr bool PERM = true;
    const float* base; float* out; const float* gn; hf* xg; float* pss; int ldc; float scale;
    __device__ __forceinline__ void operator()(const f32x4 (&acc)[2][2][4][2], const Unit& u, int ui, int wr, int wc, int fr, int fq) const {
        const int row0 = u.pm * BM + wr * 64 + fr, col0 = u.pn * BM + wc * 32 + 8 * fq;
        f32x4 gg[2][2];
#pragma unroll
        for (int bj = 0; bj < 2; ++bj)
#pragma unroll
            for (int n = 0; n < 2; ++n) gg[bj][n] = gn ? *(const f32x4*)(gn + col0 + bj * HALF + n * 4) : (f32x4){0.f, 0.f, 0.f, 0.f};
#pragma unroll
        for (int ai = 0; ai < 2; ++ai)
#pragma unroll
            for (int mp = 0; mp < 2; ++mp) {
                f32x4 b[2][2][2];
#pragma unroll
                for (int mm = 0; mm < 2; ++mm) { const size_t off = (size_t)(row0 + ai * HALF + (mp * 2 + mm) * 16) * ldc + col0;
#pragma unroll
                    for (int bj = 0; bj < 2; ++bj)
#pragma unroll
                        for (int n = 0; n < 2; ++n) b[mm][bj][n] = *(const f32x4*)(base + off + bj * HALF + n * 4); }
                __builtin_amdgcn_sched_barrier(0);
#pragma unroll
                for (int mm = 0; mm < 2; ++mm) { const int m = mp * 2 + mm, row = row0 + ai * HALF + m * 16; const size_t off = (size_t)row * ldc + col0; float ss = 0.f;
#pragma unroll
                    for (int bj = 0; bj < 2; ++bj) { h8 w;
#pragma unroll
                        for (int n = 0; n < 2; ++n) { const f32x4 o = b[mm][bj][n] + acc[ai][bj][m][n] * scale; *(f32x4*)(out + off + bj * HALF + n * 4) = o;
#pragma unroll
                            for (int j = 0; j < 4; ++j) { w[n * 4 + j] = (hf)(o[j] * gg[bj][n][j]); ss += o[j] * o[j]; } }
                        if (gn) *(h8*)(xg + off + bj * HALF) = w; }
                    if (gn) { ss += __shfl_xor(ss, 16); ss += __shfl_xor(ss, 32); if (fq == 0) pss[(size_t)row * 32 + u.pn * 4 + wc] = ss; } }
                __builtin_amdgcn_sched_barrier(0);
            }
    }
};
struct EpiH16 {
    static constexpr bool PERM = true;
    hf* C; int ldc; LAS const float* rs;
    __device__ __forceinline__ void operator()(const f32x4 (&acc)[2][2][4][2], const Unit& u, int ui, int wr, int wc, int fr, int fq) const {
        const int row0 = u.pm * BM + wr * 64 + fr, col0 = u.pn * BM + wc * 32 + 8 * fq;
#pragma unroll
        for (int ai = 0; ai < 2; ++ai)
#pragma unroll
            for (int m = 0; m < 4; ++m) { hf* rowp = C + (size_t)(row0 + ai * HALF + m * 16) * ldc + col0; const float sc = rs[ui * 256 + wr * 64 + fr + ai * HALF + m * 16];
#pragma unroll
                for (int bj = 0; bj < 2; ++bj) { h8 w;
#pragma unroll
                    for (int n = 0; n < 2; ++n)
#pragma unroll
                        for (int j = 0; j < 4; ++j) w[n * 4 + j] = (hf)(acc[ai][bj][m][n][j] * sc);
                    *(h8*)(rowp + bj * HALF) = w; } }
    }
};
struct EpiSwiGLU {
    static constexpr bool PERM = true;
    hf* O; int ldc; LAS const float* rs;
    __device__ __forceinline__ void operator()(const f32x4 (&acc)[2][2][4][2], const Unit& u, int ui, int wr, int wc, int fr, int fq) const {
        const int row0 = u.pm * BM + wr * 64 + fr, col0 = u.pn * HALF + wc * 32 + 8 * fq;
#pragma unroll
        for (int ai = 0; ai < 2; ++ai)
#pragma unroll
            for (int m = 0; m < 4; ++m) { hf* rowp = O + (size_t)(row0 + ai * HALF + m * 16) * ldc + col0; h8 w; const float sc = rs[ui * 256 + wr * 64 + fr + ai * HALF + m * 16];
#pragma unroll
                for (int n = 0; n < 2; ++n)
#pragma unroll
                    for (int j = 0; j < 4; ++j) { const float g = acc[ai][0][m][n][j] * sc, up = acc[ai][1][m][n][j] * sc; const float sg = g * __builtin_amdgcn_rcpf(1.0f + __expf(-g)); w[n * 4 + j] = (hf)(sg * up); }
                *(h8*)rowp = w; }
    }
};
template <class Sched>
__device__ __forceinline__ void fill_rs(LAS float* RS, const float* pss, const Sched& S) {
    const int tid = otid(); const int r = tid >> 1, hh = tid & 1;
    f32x4 v[6][4]; unsigned okm = 0u;
#pragma unroll
    for (int ui = 0; ui < 6; ++ui) { Unit u; u.pm = 0; u.pn = 0; const bool ok = S.next(ui, u); okm |= ok ? (1u << ui) : 0u;
        const float* pp = pss + (size_t)((ok ? u.pm : 0) * BM + r) * 32 + hh * 16;
#pragma unroll
        for (int e = 0; e < 4; ++e) v[ui][e] = *(const f32x4*)(pp + e * 4); }
#pragma unroll
    for (int ui = 0; ui < 6; ++ui) { float a = 0.f;
#pragma unroll
        for (int e = 0; e < 4; ++e) a += (v[ui][e][0] + v[ui][e][1]) + (v[ui][e][2] + v[ui][e][3]);
        a += __shfl_xor(a, 1);
        if (hh == 0 && ((okm >> ui) & 1u)) RS[ui * 256 + r] = rsqrtf(a * (1.0f / DM) + 1e-6f); }
    __syncthreads();
}
template <class Epi, class Sched>
__device__ __forceinline__ void gemm_phase(LAS unsigned char* lds, const Gemm g, const Sched& S, const Epi& E) {
    int tid = threadIdx.x; asm volatile("" : "+v"(tid));
    const int wid = __builtin_amdgcn_readfirstlane(tid >> 6), lane = tid & 63, wr = wid >> 2, wc = wid & 3, fr = lane & 15, fq = lane >> 4;
    const int K = g.K, nt = K / BK;
    unsigned voffA[2], voffB[2];
#pragma unroll
    for (int i = 0; i < 2; ++i) { int R, C; stage_rc(tid * 16 + i * 8192, R, C); const int Rb = Epi::PERM ? ((R & ~31) + perm32(R & 31)) : R;
        voffA[i] = (unsigned)(R * K + C) * 2u; voffB[i] = (unsigned)(Rb * K + C) * 2u; }
    const size_t kstep = (size_t)(BK * 2);
    const size_t hstep = (size_t)HALF * K * 2;
    const size_t tstep = 2 * hstep;
    const unsigned ldsw = (unsigned)wid * 1024u;
    const int aoff = lds_byte(wr * 64 + fr, fq * 8), boff = lds_byte(wc * 32 + fr, fq * 8);
#define PG8_SA(b, h) (((b) * 2 + (h)) * HTB)
#define PG8_SB(b, h) ((4 + (b) * 2 + (h)) * HTB)
#define PG8_STAGE(bufoff, gbase, voff) do { _Pragma("unroll") for (int _i = 0; _i < 2; ++_i) \
        __builtin_amdgcn_global_load_lds((const unsigned*)((const char*)(gbase) + (voff)[_i]), (LAS unsigned*)(lds + (bufoff) + ldsw + _i * 8192), 16, 0, 0); } while (0)
#define PG8_LDA(dst, b, h) do { _Pragma("unroll") for (int m = 0; m < 4; ++m) _Pragma("unroll") for (int k = 0; k < 2; ++k) dst[m][k] = *(const LAS h8*)(lds + PG8_SA(b, h) + aoff + m * 2048 + k * 1024); } while (0)
#define PG8_LDB(dst, b, h) do { _Pragma("unroll") for (int n = 0; n < 2; ++n) _Pragma("unroll") for (int k = 0; k < 2; ++k) dst[n][k] = *(const LAS h8*)(lds + PG8_SB(b, h) + boff + n * 2048 + k * 1024); } while (0)
#define PG8_MMA(ai, bj, At, Bt) do { __builtin_amdgcn_s_setprio(1); _Pragma("unroll") for (int m = 0; m < 4; ++m) _Pragma("unroll") for (int n = 0; n < 2; ++n) _Pragma("unroll") for (int k = 0; k < 2; ++k) \
        acc[ai][bj][m][n] = __builtin_amdgcn_mfma_f32_16x16x32_f16(Bt[n][k], At[m][k], acc[ai][bj][m][n], 0, 0, 0); __builtin_amdgcn_s_setprio(0); } while (0)
#define PG8_WAIT_V(n) asm volatile("s_waitcnt vmcnt(" #n ")" ::: "memory")
#define PG8_WAIT_L(n) asm volatile("s_waitcnt lgkmcnt(" #n ")" ::: "memory")
#define PG8_BAR __builtin_amdgcn_s_barrier()
#define PG8_SCHED __builtin_amdgcn_sched_barrier(0)
    Unit cur, nxt; int ui = 0;
    if (!S.next(0, cur)) return;
    f32x4 acc[2][2][4][2];
#pragma unroll
    for (int a = 0; a < 2; ++a)
#pragma unroll
        for (int b = 0; b < 2; ++b)
#pragma unroll
            for (int m = 0; m < 4; ++m)
#pragma unroll
                for (int n = 0; n < 2; ++n) acc[a][b][m][n] = (f32x4){0.f, 0.f, 0.f, 0.f};
    h8 At[4][2], B0[2][2], B1[2][2];
    const char* cA = (const char*)g.A + (size_t)cur.pm * tstep; const char* cB = (const char*)g.Bt + (size_t)cur.pn * tstep;
    PG8_STAGE(PG8_SB(0, 0), cB, voffB); PG8_STAGE(PG8_SB(0, 1), cB + hstep, voffB); PG8_STAGE(PG8_SA(0, 0), cA, voffA); PG8_STAGE(PG8_SA(0, 1), cA + hstep, voffA);
    if (wr == 1) PG8_BAR;
    PG8_WAIT_V(2); PG8_BAR;
    PG8_STAGE(PG8_SB(1, 0), cB + kstep, voffB); PG8_STAGE(PG8_SA(1, 0), cA + kstep, voffA); PG8_STAGE(PG8_SB(1, 1), cB + hstep + kstep, voffB);
    PG8_WAIT_V(6); PG8_BAR;
    for (;;) {
        const bool has_next = S.next(ui + 1, nxt);
        const char* nA = has_next ? (const char*)g.A + (size_t)nxt.pm * tstep : cA; const char* nB = has_next ? (const char*)g.Bt + (size_t)nxt.pn * tstep : cB;
        for (int t = 0; t < nt; t += 2) {
            const bool last = (t == nt - 2);
            const char* a1 = cA + (size_t)(t + 1) * kstep;
            const char* a2 = last ? nA : cA + (size_t)(t + 2) * kstep; const char* b2 = last ? nB : cB + (size_t)(t + 2) * kstep;
            const char* a3 = a2 + kstep; const char* b3 = b2 + kstep;
            PG8_LDB(B0, 0, 0); PG8_LDB(B1, 0, 1); PG8_SCHED; PG8_LDA(At, 0, 0); PG8_STAGE(PG8_SA(1, 1), a1 + hstep, voffA);
            PG8_WAIT_V(8); PG8_WAIT_L(0); PG8_BAR; PG8_MMA(0, 0, At, B0); PG8_MMA(0, 1, At, B1); PG8_BAR; PG8_SCHED;
            PG8_LDA(At, 0, 1); PG8_STAGE(PG8_SB(0, 0), b2, voffB); PG8_STAGE(PG8_SB(0, 1), b2 + hstep, voffB); PG8_STAGE(PG8_SA(0, 0), a2, voffA);
            PG8_WAIT_V(8); PG8_WAIT_L(0); PG8_BAR; PG8_MMA(1, 0, At, B0); PG8_MMA(1, 1, At, B1); PG8_BAR; PG8_SCHED;
            PG8_LDB(B0, 1, 0); PG8_LDB(B1, 1, 1); PG8_SCHED; PG8_LDA(At, 1, 0); PG8_STAGE(PG8_SA(0, 1), a2 + hstep, voffA);
            PG8_WAIT_V(8); PG8_WAIT_L(0); PG8_BAR; PG8_MMA(0, 0, At, B0); PG8_MMA(0, 1, At, B1); PG8_BAR; PG8_SCHED;
            PG8_LDA(At, 1, 1); PG8_STAGE(PG8_SB(1, 0), b3, voffB); PG8_STAGE(PG8_SB(1, 1), b3 + hstep, voffB); PG8_STAGE(PG8_SA(1, 0), a3, voffA);
            PG8_WAIT_V(8); PG8_WAIT_L(0); PG8_BAR; PG8_MMA(1, 0, At, B0); PG8_MMA(1, 1, At, B1); PG8_BAR; PG8_SCHED;
        }
        if (wr == 0) PG8_BAR;
        E(acc, cur, ui, wr, wc, fr, fq);
        if (!has_next) break;
#pragma unroll
        for (int a = 0; a < 2; ++a)
#pragma unroll
            for (int b = 0; b < 2; ++b)
#pragma unroll
                for (int m = 0; m < 4; ++m)
#pragma unroll
                    for (int n = 0; n < 2; ++n) acc[a][b][m][n] = (f32x4){0.f, 0.f, 0.f, 0.f};
        cur = nxt; cA = nA; cB = nB; ++ui;
        if (wr == 1) PG8_BAR;
    }
    PG8_WAIT_V(0);
    PG8_BAR;
#undef PG8_SA
#undef PG8_SB
#undef PG8_STAGE
#undef PG8_LDA
#undef PG8_LDB
#undef PG8_MMA
#undef PG8_WAIT_V
#undef PG8_WAIT_L
#undef PG8_BAR
#undef PG8_SCHED
}
}

__device__ __forceinline__ float wave_sum(float v) {
#pragma unroll
    for (int o = 32; o >= 1; o >>= 1) v += __shfl_xor(v, o);
    return v;
}
__device__ __forceinline__ float sigmoidf_(float x) { return 1.0f / (1.0f + __expf(-x)); }

struct ConvJob { const float* src; hf* dst; int K, N, mode; };
constexpr int NQJ = 20;
constexpr int QT_TOTAL = 9472;
__device__ __forceinline__ ConvJob get_job(const Params& P, int l, int j) {
    hf* wb = (hf*)(P.ws + WS_W) + (size_t)l * E_LAYER;
    ConvJob r;
    switch (j) {
    case 0: r = {P.in[4] + (size_t)l * DM * DFF, wb + O_GU1, DM, DFF, 1}; break;
    case 1: r = {P.in[5] + (size_t)l * DM * DFF, wb + O_GU1, DM, DFF, 2}; break;
    case 2: r = {P.in[6] + (size_t)l * DFF * DM, wb + O_DN1, DFF, DM, 0}; break;
    case 3: r = {P.in[8] + (size_t)l * DM * PW, wb + O_WIN, DM, PW, 0}; break;
    case 4: r = {P.in[19] + (size_t)l * DM * DM, wb + O_WOUT, DM, DM, 0}; break;
    case 5: r = {P.in[22] + (size_t)l * DM * 512, wb + O_WQ, DM, 512, 0}; break;
    case 6: r = {P.in[23] + (size_t)l * DM * 1024, wb + O_WKV, DM, 1024, 0}; break;
    case 7: r = {P.in[26] + (size_t)l * 512 * DM, wb + O_WO, 512, DM, 0}; break;
    case 8: r = {P.in[28] + (size_t)l * DM * DFF, wb + O_GU2, DM, DFF, 1}; break;
    case 9: r = {P.in[29] + (size_t)l * DM * DFF, wb + O_GU2, DM, DFF, 2}; break;
    default: r = {P.in[30] + (size_t)l * DFF * DM, wb + O_DN2, DFF, DM, 0}; break;
    }
    return r;
}
__device__ __forceinline__ void convert_tile(const ConvJob jb, int r, LAS unsigned char* lds) {
    const int tid = otid();
    LAS unsigned* T = (LAS unsigned*)lds;
    const int ntn = jb.N >> 8, tn = r % ntn, tk = r / ntn, n0 = tn * 256, k0 = tk * 64;
    const int n4 = (tid & 63) * 4, kr = tid >> 6;
    f32x4 v[8];
#pragma unroll
    for (int p = 0; p < 8; ++p) v[p] = *(const f32x4*)(jb.src + (size_t)(k0 + 2 * (kr + 8 * (p >> 1)) + (p & 1)) * jb.N + n0 + n4);
#pragma unroll
    for (int p = 0; p < 4; ++p) { const int k2 = kr + 8 * p; typedef unsigned u32x4 __attribute__((ext_vector_type(4))); u32x4 w;
#pragma unroll
        for (int e = 0; e < 4; ++e) { typedef _Float16 h2 __attribute__((ext_vector_type(2))); h2 t; t[0] = (hf)v[2 * p][e]; t[1] = (hf)v[2 * p + 1][e]; w[e] = __builtin_bit_cast(unsigned, t); }
        *(LAS u32x4*)(T + k2 * 260 + n4) = w; }
    __syncthreads();
    { const int n = tid & 255, hh = tid >> 8; const int gn = n0 + n;
      const int row = jb.mode == 0 ? gn : ((gn >> 7) * 256 + (gn & 127) + (jb.mode == 2 ? 128 : 0));
      hf* dp = jb.dst + (size_t)row * jb.K + k0 + hh * 32;
#pragma unroll
      for (int c = 0; c < 4; ++c) { typedef unsigned u32x4 __attribute__((ext_vector_type(4))); u32x4 w;
#pragma unroll
          for (int e = 0; e < 4; ++e) w[e] = T[(hh * 16 + c * 4 + e) * 260 + n];
          *(u32x4*)(dp + c * 8) = w; } }
    __syncthreads();
}
__device__ __forceinline__ void queue_tile(const Params& P, int slot, LAS unsigned char* lds) {
    constexpr int QL[NQJ] = {0, 0, 1, 0, 0, 0, 0, 0, 0, 0, 1, 1, 1, 1, 1, 1, 1, 1, 1, 1};
    constexpr int QJ[NQJ] = {2, 6, 6, 3, 4, 5, 7, 8, 9, 10, 0, 1, 2, 3, 4, 5, 7, 8, 9, 10};
    constexpr int QN[NQJ] = {704, 128, 128, 704, 256, 64, 64, 704, 704, 704, 704, 704, 704, 704, 256, 64, 64, 704, 704, 704};
    int r = slot, q = 0;
#pragma unroll
    for (int t = 0; t < NQJ - 1; ++t) { if (q == t && r >= QN[t]) { r -= QN[t]; q = t + 1; } }
    int l = 0, j = 0;
#pragma unroll
    for (int t = 0; t < NQJ; ++t) { if (q == t) { l = QL[t]; j = QJ[t]; } }
    convert_tile(get_job(P, l, j), r, lds);
}
__device__ __forceinline__ void conv_pull(const Params& P, LAS unsigned char* lds, int req, int quota) {
    LAS int* misc = (LAS int*)(lds + 115968);
    int* q = (int*)(P.ws + WS_CNT) + 32;
    for (int n = 0;; ++n) {
        __syncthreads();
        if (threadIdx.x == 0) { const int cur = __hip_atomic_load(q, __ATOMIC_RELAXED, __HIP_MEMORY_SCOPE_AGENT); int slot = -1;
            if (cur < QT_TOTAL && (cur < req || n < quota)) slot = atomicAdd(q, 1);
            misc[0] = slot; }
        __syncthreads();
        const int slot = misc[0];
        if (slot < 0 || slot >= QT_TOTAL) break;
        queue_tile(P, slot, lds);
    }
}
__device__ __forceinline__ void convert_static(const Params& P, LAS unsigned char* lds, int bid, int nb) {
    for (int idx = bid; idx < 1408; idx += nb) { const int j = idx >= 704; convert_tile(get_job(P, 0, j), idx - j * 704, lds); }
}

__device__ __forceinline__ void norm_rows(const float* __restrict__ src, const float* __restrict__ g, hf* __restrict__ dst, int nrows, int bid, int nb, float* pss = nullptr) {
    const int tid = otid(), wid = tid >> 6, lane = tid & 63;
    for (int row = bid * 8 + wid; row < nrows; row += nb * 8) {
        const float* rp = src + (size_t)row * DM; f32x4 v[8]; float ss = 0.f;
#pragma unroll
        for (int e = 0; e < 8; ++e) { v[e] = *(const f32x4*)(rp + e * 256 + lane * 4); ss += v[e][0] * v[e][0] + v[e][1] * v[e][1] + v[e][2] * v[e][2] + v[e][3] * v[e][3]; }
        ss = wave_sum(ss); float r = rsqrtf(ss * (1.0f / DM) + 1e-6f);
        if (pss) { r = 1.0f; if (lane < 32) pss[(size_t)row * 32 + lane] = lane == 0 ? ss : 0.f; }
#pragma unroll
        for (int e = 0; e < 8; ++e) { const f32x4 gg = *(const f32x4*)(g + e * 256 + lane * 4); h4 w;
#pragma unroll
            for (int j = 0; j < 4; ++j) w[j] = (hf)(v[e][j] * r * gg[j]);
            *(h4*)(dst + (size_t)row * DM + e * 256 + lane * 4) = w; }
    }
}

__device__ __forceinline__ void memkv_post(const Params& P, int bid, int nb) {
    const int tid = otid(), wid = tid >> 6, lane = tid & 63;
    const float* KV = (const float*)(P.ws + WS_MEMKV); hf* MK = (hf*)(P.ws + WS_MEMK); hf* MVT = (hf*)(P.ws + WS_MEMVT);
    for (int row = bid * 8 + wid; row < 2048; row += nb * 8) {
        const int l = row >> 10, b = (row >> 8) & 3, m = row & 255; const float* rp = KV + (size_t)row * 1024;
        const float* kn = P.in[25] + l * 128;
#pragma unroll
        for (int c = 0; c < 2; ++c) {
            const f32x4 v = *(const f32x4*)(rp + c * 256 + lane * 4); float ss = v[0] * v[0] + v[1] * v[1] + v[2] * v[2] + v[3] * v[3];
#pragma unroll
            for (int o = 16; o >= 1; o >>= 1) ss += __shfl_xor(ss, o);
            const float r = rsqrtf(ss * (1.0f / 128) + 1e-6f); const int h = c * 2 + (lane >> 5), d = (lane & 31) * 4; const f32x4 gg = *(const f32x4*)(kn + d); h4 w;
#pragma unroll
            for (int j = 0; j < 4; ++j) w[j] = (hf)(v[j] * r * gg[j]);
            *(h4*)(MK + ((size_t)((l * 4 + b) * 4 + h) * 256 + m) * 128 + d) = w;
        }
#pragma unroll
        for (int c = 0; c < 2; ++c) {
            const f32x4 v = *(const f32x4*)(rp + 512 + c * 256 + lane * 4); const int h = c * 2 + (lane >> 5), d = (lane & 31) * 4;
#pragma unroll
            for (int j = 0; j < 4; ++j) MVT[((size_t)((l * 4 + b) * 4 + h) * 128 + d + j) * 256 + m] = (hf)v[j];
        }
    }
}

__device__ __forceinline__ f32x4 ldh4(const hf* p) { const h4 v = *(const h4*)p; return (f32x4){(float)v[0], (float)v[1], (float)v[2], (float)v[3]}; }
__device__ __forceinline__ f32x4 h4f(const h4 v) { return (f32x4){(float)v[0], (float)v[1], (float)v[2], (float)v[3]}; }
__device__ __forceinline__ void post_proj(const Params& P, int l, LAS unsigned char* lds, int bid, int nb) {
    const int tid = otid(), wid = tid >> 6, lane = tid & 63;
    const hf* PROJ = (const hf*)(P.ws + WS_BIG); float* U = (float*)(P.ws + WS_U);
    hf* MQ = (hf*)(P.ws + WS_MQ); hf* MK = (hf*)(P.ws + WS_MK); hf* MVT = (hf*)(P.ws + WS_MVT);
    hf* DQ = (hf*)(P.ws + WS_DQ); hf* DK = (hf*)(P.ws + WS_DK); hf* DVT = (hf*)(P.ws + WS_DVT); float* KPART = (float*)(P.ws + WS_KPART);
    const float* gmq = P.in[13] + l * 128; const float* gmk = P.in[14] + l * 128; const float* gdq = P.in[15] + l * 64; const float* gdk = P.in[16] + l * 64;
    LAS hf* T = (LAS hf*)lds;
    LAS float* KR = (LAS float*)(lds + 122880);
    const float sc_m = 0.08838834764831845f * LOG2E, sc_d = 0.125f * LOG2E;
    for (int item = bid; item < MT / 32; item += nb) {
        const int b = item >> 6, s0 = (item & 63) * 32;
        f32x4 ksum[3];
#pragma unroll
        for (int c = 0; c < 3; ++c) ksum[c] = (f32x4){0.f, 0.f, 0.f, 0.f};
        h4 rawn[22];
        { const hf* rp0 = PROJ + ((size_t)b * SQ + s0 + wid * 4) * PW;
#pragma unroll
          for (int c = 0; c < 22; ++c) rawn[c] = *(const h4*)(rp0 + c * 256 + lane * 4); }
        for (int it = 0; it < 4; ++it) {
            const int tl = wid * 4 + it, s = s0 + tl; const size_t tok = (size_t)b * SQ + s;
            h4 raw[22];
#pragma unroll
            for (int c = 0; c < 22; ++c) raw[c] = rawn[c];
            { const int itn = it < 3 ? it + 1 : 3; const hf* rpn = PROJ + ((size_t)b * SQ + s0 + wid * 4 + itn) * PW;
#pragma unroll
              for (int c = 0; c < 22; ++c) rawn[c] = *(const h4*)(rpn + c * 256 + lane * 4); }
            __builtin_amdgcn_sched_barrier(0);
#pragma unroll
            for (int c = 0; c < 2; ++c) { const f32x4 a = h4f(raw[c]), gg = h4f(raw[2 + c]); f32x4 u;
#pragma unroll
                for (int j = 0; j < 4; ++j) u[j] = a[j] * sigmoidf_(gg[j]);
                *(f32x4*)(U + tok * 512 + c * 256 + lane * 4) = u; }
#pragma unroll
            for (int c = 0; c < 3; ++c) {
                const int h = c * 2 + (lane >> 5), d = (lane & 31) * 4;
                { const f32x4 v = h4f(raw[4 + c]); float ss = v[0] * v[0] + v[1] * v[1] + v[2] * v[2] + v[3] * v[3];
#pragma unroll
                  for (int o = 16; o >= 1; o >>= 1) ss += __shfl_xor(ss, o);
                  const float r = rsqrtf(ss * (1.0f / 128) + 1e-6f) * sc_m; const f32x4 gg = *(const f32x4*)(gmq + d); h4 w;
#pragma unroll
                  for (int j = 0; j < 4; ++j) w[j] = (hf)(v[j] * r * gg[j]);
                  *(h4*)(MQ + ((size_t)(b * 6 + h) * SQ + s) * 128 + d) = w; }
                { const f32x4 v = h4f(raw[7 + c]); float ss = v[0] * v[0] + v[1] * v[1] + v[2] * v[2] + v[3] * v[3];
#pragma unroll
                  for (int o = 16; o >= 1; o >>= 1) ss += __shfl_xor(ss, o);
                  const float r = rsqrtf(ss * (1.0f / 128) + 1e-6f); const f32x4 gg = *(const f32x4*)(gmk + d); h4 w;
#pragma unroll
                  for (int j = 0; j < 4; ++j) { const float kn = v[j] * r * gg[j]; w[j] = (hf)kn; ksum[c][j] += kn; }
                  *(h4*)(MK + ((size_t)(b * 6 + h) * SQ + s) * 128 + d) = w; }
                { const f32x4 v = h4f(raw[10 + c]);
#pragma unroll
                  for (int j = 0; j < 4; ++j) T[(c * 256 + lane * 4 + j) * 40 + tl] = (hf)v[j]; }
            }
#pragma unroll
            for (int c = 0; c < 3; ++c) {
                const int hc = c * 4 + (lane >> 4), d = (lane & 15) * 4;
                { const f32x4 v = h4f(raw[13 + c]); float ss = v[0] * v[0] + v[1] * v[1] + v[2] * v[2] + v[3] * v[3];
#pragma unroll
                  for (int o = 8; o >= 1; o >>= 1) ss += __shfl_xor(ss, o);
                  const float r = rsqrtf(ss * (1.0f / 64) + 1e-6f) * sc_d; const f32x4 gg = *(const f32x4*)(gdq + d); h4 w;
#pragma unroll
                  for (int j = 0; j < 4; ++j) w[j] = (hf)(v[j] * r * gg[j]);
                  *(h4*)(DQ + ((size_t)(b * 12 + hc) * SQ + s) * 64 + d) = w; }
                { const f32x4 v = h4f(raw[16 + c]); float ss = v[0] * v[0] + v[1] * v[1] + v[2] * v[2] + v[3] * v[3];
#pragma unroll
                  for (int o = 8; o >= 1; o >>= 1) ss += __shfl_xor(ss, o);
                  const float r = rsqrtf(ss * (1.0f / 64) + 1e-6f); const f32x4 gg = *(const f32x4*)(gdk + d); h4 w;
#pragma unroll
                  for (int j = 0; j < 4; ++j) w[j] = (hf)(v[j] * r * gg[j]);
                  *(h4*)(DK + ((size_t)(b * 12 + hc) * SQ + s) * 64 + d) = w; }
                { const f32x4 v = h4f(raw[19 + c]);
#pragma unroll
                  for (int j = 0; j < 4; ++j) T[(768 + c * 256 + lane * 4 + j) * 40 + tl] = (hf)v[j]; }
            }
        }
#pragma unroll
        for (int c = 0; c < 3; ++c) *(LAS f32x4*)(KR + wid * 768 + c * 256 + lane * 4) = ksum[c];
        __syncthreads();
        for (int e = tid; e < 768; e += 512) { float a = 0.f;
#pragma unroll
            for (int w = 0; w < 8; ++w) a += KR[w * 768 + e];
            KPART[(size_t)item * 768 + e] = a; }
        for (int rr = tid; rr < 1536; rr += 512) {
            const int v2 = rr >= 768, r7 = rr - v2 * 768, h = r7 >> 7, d = r7 & 127; hf* dstp = (v2 ? DVT : MVT) + ((size_t)(b * 6 + h) * 128 + d) * SQ + s0;
#pragma unroll
            for (int q = 0; q < 4; ++q) *(h8*)(dstp + q * 8) = *(const LAS h8*)(T + rr * 40 + q * 8);
        }
        __syncthreads();
    }
}

__device__ __forceinline__ void conv_item(const Params& P, int l, LAS unsigned char* lds, int item) {
    const int tid = otid(), wid = tid >> 6, lane = tid & 63;
    const float* U = (const float*)(P.ws + WS_U); hf* Y = (hf*)(P.ws + WS_YCAT);
    const float* cw = P.in[9] + (size_t)l * CONVW * CONVC; const float* cb = P.in[10] + l * CONVC; const float* lg = P.in[11] + l * CONVC; const float* lb = P.in[12] + l * CONVC;
    const int b = item >> 7, s0 = (item & 127) * 16; const int ch = wid * 64 + lane;
    LAS float* UL = (LAS float*)lds;
    LAS float* ST = (LAS float*)(lds + 46 * 2048);
    float w[CONVW];
#pragma unroll
    for (int j = 0; j < CONVW; ++j) w[j] = cw[j * CONVC + ch];
    { f32x4 v[12];
#pragma unroll
      for (int k = 0; k < 12; ++k) { const int e = tid + 512 * k, r = e >> 7, c4 = (e & 127) * 4, s = s0 - 30 + r; const int sc = s < 0 ? 0 : s;
          v[k] = (e < 46 * 128) ? *(const f32x4*)(U + ((size_t)b * SQ + sc) * 512 + c4) : (f32x4){0.f, 0.f, 0.f, 0.f}; if (s < 0) v[k] = (f32x4){0.f, 0.f, 0.f, 0.f}; }
      __builtin_amdgcn_sched_barrier(0);
#pragma unroll
      for (int k = 0; k < 12; ++k) { const int e = tid + 512 * k, r = e >> 7, c4 = (e & 127) * 4; if (e < 46 * 128) *(LAS f32x4*)(UL + r * 512 + c4) = v[k]; } }
    __syncthreads();
    float u[46];
#pragma unroll
    for (int r = 0; r < 46; ++r) u[r] = UL[r * 512 + ch];
    const float bias = cb[ch]; float acc[16];
#pragma unroll
    for (int t = 0; t < 16; ++t) { float a = bias;
#pragma unroll
        for (int j = 0; j < CONVW; ++j) a += w[j] * u[t + j];
        acc[t] = a; }
#pragma unroll
    for (int t = 0; t < 16; ++t) { const float s1 = wave_sum(acc[t]), s2 = wave_sum(acc[t] * acc[t]); if (lane == 0) { ST[(wid * 16 + t) * 2] = s1; ST[(wid * 16 + t) * 2 + 1] = s2; } }
    __syncthreads();
    const float g = lg[ch], be = lb[ch];
#pragma unroll
    for (int t = 0; t < 16; ++t) { float s1 = 0.f, s2 = 0.f;
#pragma unroll
        for (int w8 = 0; w8 < 8; ++w8) { s1 += ST[(w8 * 16 + t) * 2]; s2 += ST[(w8 * 16 + t) * 2 + 1]; }
        const float mu = s1 * (1.0f / 512), var = fmaxf(s2 * (1.0f / 512) - mu * mu, 0.f), rstd = rsqrtf(var + 1e-5f);
        const float y = (acc[t] - mu) * rstd * g + be;
        Y[((size_t)b * SQ + s0 + t) * DM + ch] = (hf)(y * sigmoidf_(y)); }
}

constexpr int A_STG = 0, A_STG_BYTES = 35840, A_QS = 71680, A_LUT = 106496, A_TK0 = 107520, A_SELM = 107776, A_KM = 108288, A_GATE = 111872, A_MISC = 115968;
constexpr int VSTR = 144;
template <int DQK, bool CAUSAL, bool BIAS, bool SEL>
__device__ __forceinline__ void flash_tile(LAS const unsigned char* kb, LAS const float* lut, const h8 (&qf)[DQK / 32], int k0, int q0w, int qpos, int i, int g, unsigned selmask, f32x4 (&O)[8], float& mrow, float& lsum) {
    constexpr int KT_BYTES = DQK * 128, NKK = DQK / 32;
    const bool selok = SEL ? ((selmask >> (k0 >> 8)) & 1u) : true;
    const bool active = (!CAUSAL || k0 <= q0w + 15) && (!SEL || __ballot(selok) != 0ull);
    if (!active) return;
    LAS const unsigned char* vb = kb + KT_BYTES;
    f32x4 sa[4];
    { h8 kf[4][NKK];
#pragma unroll
      for (int st = 0; st < 4; ++st)
#pragma unroll
          for (int kk = 0; kk < NKK; ++kk) kf[st][kk] = *(const LAS h8*)(kb + (kk * 4 + g) * 1024 + (16 * st + i) * 16);
      __builtin_amdgcn_sched_barrier(0);
#pragma unroll
      for (int st = 0; st < 4; ++st) sa[st] = (f32x4){0.f, 0.f, 0.f, 0.f};
#pragma unroll
      for (int kk = 0; kk < NKK; ++kk)
#pragma unroll
          for (int st = 0; st < 4; ++st) sa[st] = __builtin_amdgcn_mfma_f32_16x16x32_f16(kf[st][kk], qf[kk], sa[st], 0, 0, 0); }
    h8 vf[8][2];
#pragma unroll
    for (int dt = 0; dt < 8; ++dt)
#pragma unroll
        for (int s2 = 0; s2 < 2; ++s2) vf[dt][s2] = *(const LAS h8*)(vb + (4 * s2 + g) * 2048 + (16 * dt + i) * 16);
    __builtin_amdgcn_sched_barrier(0);
    if (BIAS) {
        const bool far = (k0 + 63 + 128 <= q0w);
        if (far) { const float bc = lut[128];
#pragma unroll
            for (int st = 0; st < 4; ++st)
#pragma unroll
                for (int r = 0; r < 4; ++r) sa[st][r] += bc;
        } else {
            const int dbase = qpos - k0 - 8 * g; float bv[4][4];
#pragma unroll
            for (int st = 0; st < 4; ++st)
#pragma unroll
                for (int r = 0; r < 4; ++r) { const int dist = dbase - (32 * (st >> 1) + 4 * (st & 1) + r); const int dc = dist < 0 ? 0 : (dist > 128 ? 128 : dist); bv[st][r] = lut[dc]; }
#pragma unroll
            for (int st = 0; st < 4; ++st)
#pragma unroll
                for (int r = 0; r < 4; ++r) asm volatile("" : "+v"(bv[st][r]));
#pragma unroll
            for (int st = 0; st < 4; ++st)
#pragma unroll
                for (int r = 0; r < 4; ++r) { const int dist = dbase - (32 * (st >> 1) + 4 * (st & 1) + r); sa[st][r] = dist >= 0 ? sa[st][r] + bv[st][r] : NEGV; }
        }
    }
    if (SEL) { if (!selok) {
#pragma unroll
        for (int st = 0; st < 4; ++st)
#pragma unroll
            for (int r = 0; r < 4; ++r) sa[st][r] = NEGV; } }
    float mx = NEGV;
#pragma unroll
    for (int st = 0; st < 4; ++st)
#pragma unroll
        for (int r = 0; r < 4; ++r) mx = fmaxf(mx, sa[st][r]);
    mx = fmaxf(mx, __shfl_xor(mx, 16)); mx = fmaxf(mx, __shfl_xor(mx, 32));
    const float mnew = fmaxf(mrow, mx);
    const bool grow = mnew > mrow;
    float ps = 0.f; h8 pf[2];
#pragma unroll
    for (int st = 0; st < 4; ++st)
#pragma unroll
        for (int r = 0; r < 4; ++r) { const float p = __builtin_amdgcn_exp2f(sa[st][r] - mnew); ps += p; pf[st >> 1][(st & 1) * 4 + r] = (hf)p; }
    if (__ballot(grow) != 0ull) {
        const float alpha = __builtin_amdgcn_exp2f(mrow - mnew); lsum *= alpha;
#pragma unroll
        for (int dt = 0; dt < 8; ++dt) O[dt] *= alpha;
    }
    mrow = mnew; lsum += ps;
    __builtin_amdgcn_sched_barrier(0);
#pragma unroll
    for (int s2 = 0; s2 < 2; ++s2)
#pragma unroll
        for (int dt = 0; dt < 8; ++dt) O[dt] = __builtin_amdgcn_mfma_f32_16x16x32_f16(vf[dt][s2], pf[s2], O[dt], 0, 0, 0);
}
template <int DQK, bool CAUSAL, bool BIAS, bool QLDS, bool SEL>
__device__ __forceinline__ void flash_core(LAS unsigned char* lds, const hf* Qb, const hf* Kb, const hf* VTb, int vts, int q0, int ntiles, unsigned selmask, f32x4 (&O)[8], float& lsum) {
    constexpr int KT_BYTES = DQK * 128, NKK = DQK / 32, KCH = DQK / 64, C8M = DQK / 8 - 1, RSH = (DQK == 128) ? 7 : 6;
    int tid = threadIdx.x; asm volatile("" : "+v"(tid));
    const int wid = __builtin_amdgcn_readfirstlane(tid >> 6), lane = tid & 63, i = lane & 15, g = lane >> 4;
    const int q0w = q0 + wid * 16, qpos = q0w + i;
    LAS const int* tk0 = (LAS const int*)(lds + A_TK0); LAS const float* lut = (LAS const float*)(lds + A_LUT);
    h8 qf[NKK];
#pragma unroll
    for (int kk = 0; kk < NKK; ++kk) {
        if (QLDS) qf[kk] = *(const LAS h8*)(lds + A_QS + (wid * 16 + i) * 272 + kk * 64 + g * 16);
        else qf[kk] = *(const h8*)(Qb + (size_t)qpos * DQK + kk * 32 + g * 8);
    }
#pragma unroll
    for (int dt = 0; dt < 8; ++dt) O[dt] = (f32x4){0.f, 0.f, 0.f, 0.f};
    float mrow = NEGV; lsum = 0.f;
    h8 kA[KCH], vA[2], kB[KCH], vB[2];
#define FA_LOADG(kreg, vreg, k0_) do { _Pragma("unroll") for (int e = 0; e < KCH; ++e) { const int c = tid + 512 * e, row = ((c >> RSH) << 3) | (c & 7), c8 = (c >> 3) & C8M; kreg[e] = *(const h8*)(Kb + (size_t)((k0_) + row) * DQK + c8 * 8); } \
        _Pragma("unroll") for (int e = 0; e < 2; ++e) { const int c = tid + 512 * e, d = ((c >> 6) << 3) | (c & 7), k8 = (c >> 3) & 7; vreg[e] = *(const h8*)(VTb + (size_t)d * vts + (k0_) + k8 * 8); } } while (0)
#define FA_STORE(kreg, vreg, buf_) do { LAS unsigned char* sb = lds + A_STG + (buf_) * A_STG_BYTES; \
        _Pragma("unroll") for (int e = 0; e < KCH; ++e) { const int c = tid + 512 * e, row = ((c >> RSH) << 3) | (c & 7), c8 = (c >> 3) & C8M; const int p = (row & 32) | ((row & 4) << 2) | ((row & 24) >> 1) | (row & 3); *(LAS h8*)(sb + c8 * 1024 + p * 16) = kreg[e]; } \
        _Pragma("unroll") for (int e = 0; e < 2; ++e) { const int c = tid + 512 * e, d = ((c >> 6) << 3) | (c & 7), k8 = (c >> 3) & 7; *(LAS h8*)(sb + KT_BYTES + k8 * 2048 + d * 16) = vreg[e]; } } while (0)
    const int ntm1 = ntiles - 1;
#define FA_K0(t_) tk0[(t_) < ntm1 ? (t_) : ntm1]
    { const int k00 = FA_K0(0); FA_LOADG(kA, vA, k00); }
    { const int k01 = FA_K0(1); FA_LOADG(kB, vB, k01); }
    FA_STORE(kA, vA, 0);
    __syncthreads();
    for (int t = 0; t < ntiles; t += 2) {
        { const int kn = FA_K0(t + 2); FA_LOADG(kA, vA, kn); }
        flash_tile<DQK, CAUSAL, BIAS, SEL>(lds + A_STG, lut, qf, tk0[t], q0w, qpos, i, g, selmask, O, mrow, lsum);
        FA_STORE(kB, vB, 1);
        __syncthreads();
        { const int kn = FA_K0(t + 3); FA_LOADG(kB, vB, kn); }
        if (t + 1 < ntiles) flash_tile<DQK, CAUSAL, BIAS, SEL>(lds + A_STG + A_STG_BYTES, lut, qf, tk0[t + 1], q0w, qpos, i, g, selmask, O, mrow, lsum);
        FA_STORE(kA, vA, 0);
        __syncthreads();
    }
#undef FA_K0
#undef FA_LOADG
#undef FA_STORE
}
__device__ __forceinline__ float row_total(float l) { l += __shfl_xor(l, 16); l += __shfl_xor(l, 32); return l; }

__device__ __forceinline__ int t5_bucket(int dist) {
    if (dist < 16) return dist;
    const float lr = logf((float)dist / 16.0f) / 2.0794415416798357f;
    const int v = 16 + (int)(lr * 16.0f);
    return v < 31 ? v : 31;
}
__device__ __forceinline__ void fill_lut(LAS unsigned char* lds, const float* rel_bias, int hcol) {
    LAS float* lut = (LAS float*)(lds + A_LUT);
    for (int d = otid(); d <= 128; d += 512) lut[d] = rel_bias[t5_bucket(d) * 12 + hcol] * LOG2E;
}

constexpr int D_STG_BYTES = 32768, D_K2 = 8192, D_VT = 16384;
__device__ __forceinline__ void flash_tile_dual(LAS const unsigned char* sb, LAS const float* lut, const h8 (&qa)[2], const h8 (&qb)[2], int k0, int q0w, int qpos, int i, int g,
                                                f32x4 (&O1)[8], f32x4 (&O2)[8], float& m1, float& m2, float& l1, float& l2) {
    constexpr int KSTR = 144;
    if (k0 > q0w + 15) return;
    LAS const unsigned char* vb = sb + D_VT;
    f32x4 sa[4], sc[4];
    { h8 k1[4][2], k2[4][2];
#pragma unroll
      for (int st = 0; st < 4; ++st)
#pragma unroll
          for (int kk = 0; kk < 2; ++kk) { k1[st][kk] = *(const LAS h8*)(sb + (kk * 4 + g) * 1024 + (16 * st + i) * 16); k2[st][kk] = *(const LAS h8*)(sb + D_K2 + (kk * 4 + g) * 1024 + (16 * st + i) * 16); }
      __builtin_amdgcn_sched_barrier(0);
#pragma unroll
      for (int st = 0; st < 4; ++st) { sa[st] = (f32x4){0.f, 0.f, 0.f, 0.f}; sc[st] = (f32x4){0.f, 0.f, 0.f, 0.f}; }
#pragma unroll
      for (int kk = 0; kk < 2; ++kk)
#pragma unroll
          for (int st = 0; st < 4; ++st) { sa[st] = __builtin_amdgcn_mfma_f32_16x16x32_f16(k1[st][kk], qa[kk], sa[st], 0, 0, 0); sc[st] = __builtin_amdgcn_mfma_f32_16x16x32_f16(k2[st][kk], qb[kk], sc[st], 0, 0, 0); } }
    __builtin_amdgcn_sched_barrier(0);
    const bool far = (k0 + 63 + 128 <= q0w);
    if (far) { const float bc = lut[128];
#pragma unroll
        for (int st = 0; st < 4; ++st)
#pragma unroll
            for (int r = 0; r < 4; ++r) { sa[st][r] += bc; sc[st][r] += bc; }
    } else {
        const int dbase = qpos - k0 - 8 * g; float bv[4][4];
#pragma unroll
        for (int st = 0; st < 4; ++st)
#pragma unroll
            for (int r = 0; r < 4; ++r) { const int dist = dbase - (32 * (st >> 1) + 4 * (st & 1) + r); const int dc = dist < 0 ? 0 : (dist > 128 ? 128 : dist); bv[st][r] = lut[dc]; }
#pragma unroll
        for (int st = 0; st < 4; ++st)
#pragma unroll
            for (int r = 0; r < 4; ++r) asm volatile("" : "+v"(bv[st][r]));
#pragma unroll
        for (int st = 0; st < 4; ++st)
#pragma unroll
            for (int r = 0; r < 4; ++r) { const int dist = dbase - (32 * (st >> 1) + 4 * (st & 1) + r); sa[st][r] = dist >= 0 ? sa[st][r] + bv[st][r] : NEGV; sc[st][r] = dist >= 0 ? sc[st][r] + bv[st][r] : NEGV; }
    }
    float mx1 = NEGV, mx2 = NEGV;
#pragma unroll
    for (int st = 0; st < 4; ++st)
#pragma unroll
        for (int r = 0; r < 4; ++r) { mx1 = fmaxf(mx1, sa[st][r]); mx2 = fmaxf(mx2, sc[st][r]); }
    mx1 = fmaxf(mx1, __shfl_xor(mx1, 16)); mx1 = fmaxf(mx1, __shfl_xor(mx1, 32));
    mx2 = fmaxf(mx2, __shfl_xor(mx2, 16)); mx2 = fmaxf(mx2, __shfl_xor(mx2, 32));
    const float n1 = fmaxf(m1, mx1), n2 = fmaxf(m2, mx2);
    const bool grow = (n1 > m1) || (n2 > m2);
    float p1s = 0.f, p2s = 0.f; h8 pa[2], pb[2];
#pragma unroll
    for (int st = 0; st < 4; ++st)
#pragma unroll
        for (int r = 0; r < 4; ++r) { const float p1 = __builtin_amdgcn_exp2f(sa[st][r] - n1), p2 = __builtin_amdgcn_exp2f(sc[st][r] - n2); p1s += p1; p2s += p2;
            pa[st >> 1][(st & 1) * 4 + r] = (hf)p1; pb[st >> 1][(st & 1) * 4 + r] = (hf)p2; }
    if (__ballot(grow) != 0ull) {
        const float a1 = __builtin_amdgcn_exp2f(m1 - n1), a2 = __builtin_amdgcn_exp2f(m2 - n2); l1 *= a1; l2 *= a2;
#pragma unroll
        for (int dt = 0; dt < 8; ++dt) { O1[dt] *= a1; O2[dt] *= a2; }
    }
    m1 = n1; m2 = n2; l1 += p1s; l2 += p2s;
    __builtin_amdgcn_sched_barrier(0);
#pragma unroll
    for (int s2 = 0; s2 < 2; ++s2) { h8 vf[8];
#pragma unroll
        for (int dt = 0; dt < 8; ++dt) vf[dt] = *(const LAS h8*)(vb + (4 * s2 + g) * 2048 + (16 * dt + i) * 16);
        __builtin_amdgcn_sched_barrier(0);
#pragma unroll
        for (int dt = 0; dt < 8; ++dt) { O1[dt] = __builtin_amdgcn_mfma_f32_16x16x32_f16(vf[dt], pa[s2], O1[dt], 0, 0, 0); O2[dt] = __builtin_amdgcn_mfma_f32_16x16x32_f16(vf[dt], pb[s2], O2[dt], 0, 0, 0); }
        __builtin_amdgcn_sched_barrier(0); }
}
__device__ __forceinline__ void flash_core_dual(LAS unsigned char* lds, const hf* Q1, const hf* K1, const hf* Q2, const hf* K2, const hf* VTb, int q0, int ntiles,
                                                f32x4 (&O1)[8], f32x4 (&O2)[8], float& l1, float& l2) {
    constexpr int KSTR = 144;
    int tid = threadIdx.x; asm volatile("" : "+v"(tid));
    const int wid = __builtin_amdgcn_readfirstlane(tid >> 6), lane = tid & 63, i = lane & 15, g = lane >> 4;
    const int q0w = q0 + wid * 16, qpos = q0w + i;
    LAS const float* lut = (LAS const float*)(lds + A_LUT);
    h8 qa[2], qb[2];
#pragma unroll
    for (int kk = 0; kk < 2; ++kk) { qa[kk] = *(const h8*)(Q1 + (size_t)qpos * 64 + kk * 32 + g * 8); qb[kk] = *(const h8*)(Q2 + (size_t)qpos * 64 + kk * 32 + g * 8); }
#pragma unroll
    for (int dt = 0; dt < 8; ++dt) { O1[dt] = (f32x4){0.f, 0.f, 0.f, 0.f}; O2[dt] = (f32x4){0.f, 0.f, 0.f, 0.f}; }
    float m1 = NEGV, m2 = NEGV; l1 = 0.f; l2 = 0.f;
    h8 rA[4], rB[4];
    const int krow = ((tid >> 6) << 3) | (tid & 7), kc8 = (tid >> 3) & 7;
    const int kp = (krow & 32) | ((krow & 4) << 2) | ((krow & 24) >> 1) | (krow & 3);
#define FD_LOADG(r, k0_) do { r[0] = *(const h8*)(K1 + (size_t)((k0_) + krow) * 64 + kc8 * 8); r[1] = *(const h8*)(K2 + (size_t)((k0_) + krow) * 64 + kc8 * 8); \
        _Pragma("unroll") for (int e = 0; e < 2; ++e) { const int c = tid + 512 * e, d = ((c >> 6) << 3) | (c & 7), k8 = (c >> 3) & 7; r[2 + e] = *(const h8*)(VTb + (size_t)d * SQ + (k0_) + k8 * 8); } } while (0)
#define FD_STORE(r, buf_) do { LAS unsigned char* sb = lds + A_STG + (buf_) * D_STG_BYTES; *(LAS h8*)(sb + kc8 * 1024 + kp * 16) = r[0]; *(LAS h8*)(sb + D_K2 + kc8 * 1024 + kp * 16) = r[1]; \
        _Pragma("unroll") for (int e = 0; e < 2; ++e) { const int c = tid + 512 * e, d = ((c >> 6) << 3) | (c & 7), k8 = (c >> 3) & 7; *(LAS h8*)(sb + D_VT + k8 * 2048 + d * 16) = r[2 + e]; } } while (0)
    const int ntm1 = ntiles - 1;
#define FD_K0(t_) (64 * ((t_) < ntm1 ? (t_) : ntm1))
    FD_LOADG(rA, FD_K0(0)); FD_LOADG(rB, FD_K0(1));
    FD_STORE(rA, 0);
    __syncthreads();
    for (int t = 0; t < ntiles; t += 2) {
        FD_LOADG(rA, FD_K0(t + 2));
        flash_tile_dual(lds + A_STG, lut, qa, qb, 64 * t, q0w, qpos, i, g, O1, O2, m1, m2, l1, l2);
        FD_STORE(rB, 1);
        __syncthreads();
        FD_LOADG(rB, FD_K0(t + 3));
        if (t + 1 < ntiles) flash_tile_dual(lds + A_STG + D_STG_BYTES, lut, qa, qb, 64 * (t + 1), q0w, qpos, i, g, O1, O2, m1, m2, l1, l2);
        FD_STORE(rA, 0);
        __syncthreads();
    }
#undef FD_LOADG
#undef FD_STORE
#undef FD_K0
}

__device__ __forceinline__ void diff_item(const Params& P, int l, LAS unsigned char* lds, int bh, int qt) {
    const int tid = otid(), wid = __builtin_amdgcn_readfirstlane(tid >> 6), lane = tid & 63, i = lane & 15, g = lane >> 4;
    const int b = bh / 6, h = bh % 6, q0 = qt * 128;
    const hf* DQ = (const hf*)(P.ws + WS_DQ); const hf* DK = (const hf*)(P.ws + WS_DK); const hf* DVT = (const hf*)(P.ws + WS_DVT); hf* Y = (hf*)(P.ws + WS_YCAT);
    fill_lut(lds, P.in[2], 6 + h);
    const int ntiles = (q0 + 128) / 64;
    LAS int* tk0 = (LAS int*)(lds + A_TK0);
    if (tid < ntiles) tk0[tid] = tid * 64;
    const float* lp = P.in[17] + l * 256;
    const float s1 = wave_sum(lp[lane] * lp[64 + lane]), s2 = wave_sum(lp[128 + lane] * lp[192 + lane]);
    const float lam_init = 0.8f - 0.6f * expf(-0.3f * (float)l);
    const float lam = expf(s1) - expf(s2) + lam_init;
    __syncthreads();
    const hf* VT = DVT + (size_t)(b * 6 + h) * 128 * SQ;
    f32x4 O1[8], O2[8]; float l1, l2;
    flash_core_dual(lds, DQ + (size_t)((b * 6 + h) * 2 + 0) * SQ * 64, DK + (size_t)((b * 6 + h) * 2 + 0) * SQ * 64, DQ + (size_t)((b * 6 + h) * 2 + 1) * SQ * 64, DK + (size_t)((b * 6 + h) * 2 + 1) * SQ * 64, VT, q0, ntiles, O1, O2, l1, l2);
    { const float inv = 1.0f / row_total(l1);
#pragma unroll
      for (int dt = 0; dt < 8; ++dt) O1[dt] *= inv; }
    const float inv2 = lam / row_total(l2); float ss = 0.f;
#pragma unroll
    for (int dt = 0; dt < 8; ++dt) { O1[dt] -= O2[dt] * inv2; ss += O1[dt][0] * O1[dt][0] + O1[dt][1] * O1[dt][1] + O1[dt][2] * O1[dt][2] + O1[dt][3] * O1[dt][3]; }
    ss = row_total(ss);
    const float r = rsqrtf(ss * (1.0f / 128) + 1e-6f) * (1.0f - lam_init);
    const float* sg = P.in[18] + l * 128;
    hf* yp = Y + ((size_t)b * SQ + q0 + wid * 16 + i) * DM + 1280 + h * 128;
    f32x4 gg8[8];
#pragma unroll
    for (int dt = 0; dt < 8; ++dt) gg8[dt] = *(const f32x4*)(sg + dt * 16 + g * 4);
#pragma unroll
    for (int dt = 0; dt < 8; ++dt) { h4 w;
#pragma unroll
        for (int j = 0; j < 4; ++j) w[j] = (hf)(O1[dt][j] * r * gg8[dt][j]);
        *(h4*)(yp + dt * 16 + g * 4) = w; }
}

__device__ __forceinline__ void moba_item(const Params& P, int l, LAS unsigned char* lds, int bh, int qt) {
    const int tid = otid(), wid = __builtin_amdgcn_readfirstlane(tid >> 6), lane = tid & 63, i = lane & 15, g = lane >> 4;
    const int b = bh / 6, h = bh % 6, q0 = qt * 128, cur = q0 >> 8;
    const hf* MQ = (const hf*)(P.ws + WS_MQ) + (size_t)(b * 6 + h) * SQ * 128; const hf* MK = (const hf*)(P.ws + WS_MK) + (size_t)(b * 6 + h) * SQ * 128;
    const hf* MVT = (const hf*)(P.ws + WS_MVT) + (size_t)(b * 6 + h) * 128 * SQ; const float* KPART = (const float*)(P.ws + WS_KPART); hf* Y = (hf*)(P.ws + WS_YCAT);
    fill_lut(lds, P.in[2], h);
    LAS int* tk0 = (LAS int*)(lds + A_TK0); LAS unsigned* selm = (LAS unsigned*)(lds + A_SELM); LAS float* KM = (LAS float*)(lds + A_KM); LAS float* GT = (LAS float*)(lds + A_GATE);
    LAS unsigned* misc = (LAS unsigned*)(lds + A_MISC);
    for (int e = tid; e < cur * 128; e += 512) { const int j = e >> 7, d = e & 127; float a = 0.f;
#pragma unroll
        for (int c = 0; c < 8; ++c) a += KPART[((size_t)b * 64 + j * 8 + c) * 768 + h * 128 + d];
        KM[e] = a * (1.0f / 256); }
    if (tid == 0) misc[1] = 0u;
    __syncthreads();
    {
        const int r = tid >> 2, jj = tid & 3; const hf* qp = MQ + (size_t)(q0 + r) * 128; float g0 = 0.f, g1 = 0.f;
        if (jj < cur) {
            for (int hb = 0; hb < 4; ++hb) { h8 qv[4];
#pragma unroll
                for (int d8 = 0; d8 < 4; ++d8) qv[d8] = *(const h8*)(qp + (hb * 4 + d8) * 8);
                __builtin_amdgcn_sched_barrier(0);
#pragma unroll
                for (int d8 = 0; d8 < 4; ++d8) {
#pragma unroll
                    for (int e = 0; e < 8; ++e) { const float qx = (float)qv[d8][e]; g0 += qx * KM[jj * 128 + (hb * 4 + d8) * 8 + e]; if (jj + 4 < cur) g1 += qx * KM[(jj + 4) * 128 + (hb * 4 + d8) * 8 + e]; } } }
        }
        GT[r * 8 + jj] = g0; GT[r * 8 + jj + 4] = g1;
    }
    __syncthreads();
    if (tid < 128) {
        unsigned m = 0u;
        if (cur <= 3) m = (1u << cur) - 1u;
        else {
            for (int k = 0; k < 3; ++k) { float best = -3.0e38f; int bi = 0;
                for (int j = 0; j < cur; ++j) { const float v = GT[tid * 8 + j]; if (!((m >> j) & 1u) && v > best) { best = v; bi = j; } }
                m |= 1u << bi; }
        }
        selm[tid] = m | (1u << cur);
        atomicOr((unsigned*)&misc[1], m);
    }
    __syncthreads();
    const unsigned vis = misc[1];
    int ntiles = 0;
    {
        const int own_t = (q0 + 128 - cur * 256) / 64;
        if (tid == 0) { int n = 0; for (int t = 0; t < own_t; ++t) tk0[n++] = cur * 256 + t * 64; for (int j = 0; j < cur; ++j) if ((vis >> j) & 1u) for (int t = 0; t < 4; ++t) tk0[n++] = j * 256 + t * 64; }
        ntiles = own_t + 4 * __popc(vis);
    }
    __syncthreads();
    const unsigned mysel = selm[wid * 16 + i];
    f32x4 O[8]; float ls;
    flash_core<128, true, true, false, true>(lds, MQ, MK, MVT, SQ, q0, ntiles, mysel, O, ls);
    const float inv = 1.0f / row_total(ls);
    hf* yp = Y + ((size_t)b * SQ + q0 + wid * 16 + i) * DM + 512 + h * 128;
#pragma unroll
    for (int dt = 0; dt < 8; ++dt) { h4 w;
#pragma unroll
        for (int j = 0; j < 4; ++j) w[j] = (hf)(O[dt][j] * inv);
        *(h4*)(yp + dt * 16 + g * 4) = w; }
}

__device__ __forceinline__ void mem_item(const Params& P, int l, LAS unsigned char* lds, int item) {
    const int tid = otid(), wid = __builtin_amdgcn_readfirstlane(tid >> 6), lane = tid & 63, i = lane & 15, g = lane >> 4;
    const int qt = item & 15, h = (item >> 4) & 3, b = item >> 6, q0 = qt * 128;
    const float* QF = (const float*)(P.ws + WS_BIG); hf* OM = (hf*)(P.ws + WS_OMEM);
    const hf* K = (const hf*)(P.ws + WS_MEMK) + (size_t)((l * 4 + b) * 4 + h) * 256 * 128; const hf* VT = (const hf*)(P.ws + WS_MEMVT) + (size_t)((l * 4 + b) * 4 + h) * 128 * 256;
    LAS int* tk0 = (LAS int*)(lds + A_TK0);
    if (tid < 4) tk0[tid] = tid * 64;
    { const int r = tid >> 2, qq = tid & 3; const float* qp = QF + ((size_t)b * SQ + q0 + r) * 512 + h * 128 + qq * 32; f32x4 v[8]; float ss = 0.f;
#pragma unroll
      for (int e = 0; e < 8; ++e) { v[e] = *(const f32x4*)(qp + e * 4); ss += v[e][0] * v[e][0] + v[e][1] * v[e][1] + v[e][2] * v[e][2] + v[e][3] * v[e][3]; }
      ss += __shfl_xor(ss, 1); ss += __shfl_xor(ss, 2);
      const float rr = rsqrtf(ss * (1.0f / 128) + 1e-6f) * (0.08838834764831845f * LOG2E); const float* gq = P.in[24] + l * 128 + qq * 32;
#pragma unroll
      for (int e = 0; e < 8; ++e) { const f32x4 gg = *(const f32x4*)(gq + e * 4); h4 w;
#pragma unroll
          for (int j = 0; j < 4; ++j) w[j] = (hf)(v[e][j] * rr * gg[j]);
          *(LAS h4*)(lds + A_QS + r * 272 + (qq * 32 + e * 4) * 2) = w; } }
    __syncthreads();
    f32x4 O[8]; float ls;
    flash_core<128, false, false, true, false>(lds, nullptr, K, VT, 256, q0, 4, 0xffffffffu, O, ls);
    const float inv = 1.0f / row_total(ls);
    hf* yp = OM + ((size_t)b * SQ + q0 + wid * 16 + i) * 512 + h * 128;
#pragma unroll
    for (int dt = 0; dt < 8; ++dt) { h4 w;
#pragma unroll
        for (int j = 0; j < 4; ++j) w[j] = (hf)(O[dt][j] * inv);
        *(h4*)(yp + dt * 16 + g * 4) = w; }
}

__device__ __forceinline__ int next_item(LAS unsigned char* lds, int* cnt) {
    LAS int* misc = (LAS int*)(lds + A_MISC);
    __syncthreads();
    if (threadIdx.x == 0) misc[0] = atomicAdd(cnt, 1);
    __syncthreads();
    return misc[0];
}

__global__ void __launch_bounds__(512, 2) fwd_mega(Params P) {
    extern __shared__ __attribute__((aligned(16))) unsigned char smem[];
    LAS unsigned char* lds = (LAS unsigned char*)smem;
    cg::grid_group grid = cg::this_grid();
    const int bid = blockIdx.x, nb = gridDim.x;
    const int lo = P.ph_lo, hi = P.ph_hi;
    int ph = 0;
#ifndef TIMING_MASK
#define TIMING_MASK 0
#endif
#ifndef TIMING_AMP
#define TIMING_AMP 4
#endif
    unsigned long long tsel = 0, tph0 = 0;
#define PHASE_BEGIN(cat) if (ph >= lo && ph < hi) { if (TIMING_MASK & (1 << (cat))) tph0 = __builtin_amdgcn_s_memrealtime();
#define PHASE_END(cat) if (ph + 1 < hi) grid.sync(); if (TIMING_MASK & (1 << (cat))) tsel += __builtin_amdgcn_s_memrealtime() - tph0; } ++ph;
    hf* H = (hf*)(P.ws + WS_H); hf* HID = (hf*)(P.ws + WS_BIG); float* PROJ = (float*)(P.ws + WS_BIG); hf* YC = (hf*)(P.ws + WS_YCAT); hf* OM = (hf*)(P.ws + WS_OMEM);
    int* CNT = (int*)(P.ws + WS_CNT);
    float* X = P.out;

    float* PSS = (float*)(P.ws + WS_PSS);
    LAS float* RS = (LAS float*)(lds + 131072);
    PHASE_BEGIN(0)
        if (bid == 0 && threadIdx.x < 64) CNT[threadIdx.x] = 0;
        convert_static(P, lds, bid, nb);
        for (int l = 0; l < NL; ++l) norm_rows(P.in[1], P.in[21] + l * DM, (hf*)(P.ws + WS_MEMH) + (size_t)l * 1024 * DM, 1024, bid, nb);
        norm_rows(P.in[0], P.in[3], H, MT, bid, nb, PSS);
    PHASE_END(0)

    constexpr int QG = 6;
    for (int l = 0; l < NL; ++l) {
        const hf* W = (const hf*)(P.ws + WS_W) + (size_t)l * E_LAYER;
        const float* xin = (l == 0) ? P.in[0] : X;
        PHASE_BEGIN(1)
            { pg8::Gemm g{H, W + O_GU1, MT, 2 * DFF, DM}; pg8::StaticOrder S; S.init(MT, 2 * DFF, nb, bid); pg8::fill_rs(RS, PSS, S); pg8::EpiSwiGLU E{HID, DFF, RS}; pg8::gemm_phase(lds, g, S, E); }
            conv_pull(P, lds, l == 0 ? 704 : 6272, bid >= 128 ? QG : 0);
        PHASE_END(1)
        PHASE_BEGIN(2)
            { pg8::Gemm g{HID, W + O_DN1, MT, DM, DFF}; pg8::StaticOrder S; S.init(MT, DM, nb, bid); pg8::EpiRes E{xin, X, P.in[7] + l * DM, H, PSS, DM, 0.5f}; pg8::gemm_phase(lds, g, S, E); }
            conv_pull(P, lds, l == 0 ? 1664 : 6976, 0);
        PHASE_END(2)
        PHASE_BEGIN(4)
            { pg8::Gemm g{H, W + O_WIN, MT, PW, DM}; pg8::StaticOrder S; S.init(MT, PW, nb, bid); pg8::fill_rs(RS, PSS, S); pg8::EpiH16 E{(hf*)(P.ws + WS_BIG), PW, RS}; pg8::gemm_phase(lds, g, S, E); }
            if (l == 0) {
                for (int l2 = 0; l2 < NL; ++l2) { pg8::Gemm g{(const hf*)(P.ws + WS_MEMH) + (size_t)l2 * 1024 * DM, (const hf*)(P.ws + WS_W) + (size_t)l2 * E_LAYER + O_WKV, 1024, 1024, DM};
                    pg8::StaticOrder S; S.init(1024, 1024, nb, (bid + nb - 192 - 16 * l2) % nb); pg8::EpiF32 E{(float*)(P.ws + WS_MEMKV) + (size_t)l2 * 1024 * 1024, 1024, nullptr}; pg8::gemm_phase(lds, g, S, E); }
            }
            conv_pull(P, lds, l == 0 ? 1920 : 7232, (bid >= (l == 0 ? 224 : 192)) ? QG : 0);
        PHASE_END(4)
        PHASE_BEGIN(5)
            post_proj(P, l, lds, bid, nb);
            if (l == 0) memkv_post(P, bid, nb);
        PHASE_END(5)
        PHASE_BEGIN(6)
            for (;;) {
                const int it = next_item(lds, CNT + l * 4 + 0);
                if (it >= 768 + 512) break;
                if (it < 768) { const int rnd = it / 48, w = it % 48, qt = 15 - rnd; if (w < 24) diff_item(P, l, lds, w, qt); else moba_item(P, l, lds, w - 24, qt); }
                else conv_item(P, l, lds, it - 768);
            }
        PHASE_END(6)
        PHASE_BEGIN(7)
            { pg8::Gemm g{YC, W + O_WOUT, MT, DM, DM}; pg8::StaticOrder S; S.init(MT, DM, nb, bid); pg8::EpiRes E{X, X, P.in[20] + l * DM, H, PSS, DM, 1.0f}; pg8::gemm_phase(lds, g, S, E); }
            conv_pull(P, lds, l == 0 ? 1984 : 7296, 0);
        PHASE_END(7)
        PHASE_BEGIN(8)
            { pg8::Gemm g{H, W + O_WQ, MT, 512, DM}; pg8::StaticOrder S; S.init(MT, 512, nb, bid); pg8::fill_rs(RS, PSS, S); pg8::EpiF32 E{(float*)(P.ws + WS_BIG), 512, RS}; pg8::gemm_phase(lds, g, S, E); }
            conv_pull(P, lds, l == 0 ? 2048 : 7360, bid >= 64 ? QG : 0);
        PHASE_END(8)
        PHASE_BEGIN(9)
            for (int it = bid; it < 256; it += nb) { __syncthreads(); mem_item(P, l, lds, it); }
        PHASE_END(9)
        PHASE_BEGIN(10)
            { pg8::Gemm g{OM, W + O_WO, MT, DM, 512}; pg8::StaticOrder S; S.init(MT, DM, nb, bid); pg8::EpiRes E{X, X, P.in[27] + l * DM, H, PSS, DM, 1.0f}; pg8::gemm_phase(lds, g, S, E); }
            conv_pull(P, lds, l == 0 ? 3456 : 8768, 0);
        PHASE_END(10)
        PHASE_BEGIN(1)
            { pg8::Gemm g{H, W + O_GU2, MT, 2 * DFF, DM}; pg8::StaticOrder S; S.init(MT, 2 * DFF, nb, bid); pg8::fill_rs(RS, PSS, S); pg8::EpiSwiGLU E{HID, DFF, RS}; pg8::gemm_phase(lds, g, S, E); }
            conv_pull(P, lds, l == 0 ? 4160 : 9472, bid >= 128 ? QG : 0);
        PHASE_END(1)
        PHASE_BEGIN(2)
            { pg8::Gemm g{HID, W + O_DN2, MT, DM, DFF}; pg8::StaticOrder S; S.init(MT, DM, nb, bid); pg8::EpiRes E{X, X, (l + 1 < NL) ? P.in[3] + (l + 1) * DM : nullptr, H, PSS, DM, 0.5f}; pg8::gemm_phase(lds, g, S, E); }
            if (l + 1 < NL) conv_pull(P, lds, 5568, 0);
        PHASE_END(2)
    }
    if (TIMING_MASK != 0 && bid == 0 && threadIdx.x == 0) { const unsigned long long t1 = __builtin_amdgcn_s_memrealtime(); while (__builtin_amdgcn_s_memrealtime() - t1 < (unsigned long long)TIMING_AMP * tsel) __builtin_amdgcn_s_sleep(8); }
}

extern "C" void kernel_launch(void* const* d_in, const int* in_sizes, int n_in, void* d_out, int out_size, void* d_ws, size_t ws_size, hipStream_t stream) {
    static int grid_blocks = 0;
    if (grid_blocks == 0) {
        if (n_in != 31 || out_size != MT * DM || ws_size < WS_END) { fprintf(stderr, "kernel_launch: unexpected shapes (n_in %d out %d ws %zu need %zu)\n", n_in, out_size, ws_size, (size_t)WS_END); grid_blocks = -1; return; }
        int dev = 0, cus = 0, per_cu = 0;
        hipGetDevice(&dev);
        hipDeviceGetAttribute(&cus, hipDeviceAttributeMultiprocessorCount, dev);
        if (hipFuncSetAttribute((const void*)fwd_mega, hipFuncAttributeMaxDynamicSharedMemorySize, LDS_BYTES) != hipSuccess) { fprintf(stderr, "hipFuncSetAttribute failed\n"); grid_blocks = -1; return; }
        hipOccupancyMaxActiveBlocksPerMultiprocessor(&per_cu, (const void*)fwd_mega, 512, LDS_BYTES);
        if (per_cu < 1) { fprintf(stderr, "occupancy query says %d blocks per CU\n", per_cu); per_cu = 1; }
        (void)hipGetLastError();
        grid_blocks = cus;
    }
    if (grid_blocks < 0) return;
    Params p{};
    for (int i = 0; i < 31; ++i) p.in[i] = (const float*)d_in[i];
    p.out = (float*)d_out; p.ws = (unsigned char*)d_ws; p.ph_lo = 0; p.ph_hi = 1000;
    void* args[] = {&p};
    hipError_t e = hipLaunchCooperativeKernel((const void*)fwd_mega, dim3(grid_blocks), dim3(512), args, LDS_BYTES, stream);
    if (e != hipSuccess) fprintf(stderr, "cooperative launch failed: %s (grid %d)\n", hipGetErrorString(e), grid_blocks);
}
```

```cpp
#include <hip/hip_runtime.h>
#include <hip/hip_cooperative_groups.h>
#include <cstdio>
namespace cg = cooperative_groups;

#define LAS __attribute__((address_space(3)))
typedef _Float16 hf;
typedef _Float16 h8 __attribute__((ext_vector_type(8)));
typedef _Float16 h4 __attribute__((ext_vector_type(4)));
typedef float f32x4 __attribute__((ext_vector_type(4)));

constexpr int DM = 2048, NB = 4, SQ = 2048, MT = NB * SQ, DFF = 5632, PW = 5632, NL = 2;
constexpr int CONVC = 512, CONVW = 31, MEML = 256;
constexpr float LOG2E = 1.4426950408889634f;
constexpr float NEGV = -1e30f;
constexpr int LDS_BYTES = 147456;

constexpr size_t E_GU = (size_t)2 * DFF * DM, E_DN = (size_t)DM * DFF, E_WIN = (size_t)PW * DM, E_WOUT = (size_t)DM * DM, E_WQ = (size_t)512 * DM, E_WKV = (size_t)1024 * DM, E_WO = (size_t)DM * 512;
constexpr size_t O_GU1 = 0, O_DN1 = O_GU1 + E_GU, O_WIN = O_DN1 + E_DN, O_WOUT = O_WIN + E_WIN, O_WQ = O_WOUT + E_WOUT, O_WKV = O_WQ + E_WQ, O_WO = O_WKV + E_WKV, O_GU2 = O_WO + E_WO, O_DN2 = O_GU2 + E_GU, E_LAYER = O_DN2 + E_DN;
constexpr size_t WS_W = 0;
constexpr size_t WS_H = WS_W + 2 * E_LAYER * 2;
constexpr size_t WS_BIG = WS_H + (size_t)MT * DM * 2;
constexpr size_t WS_U = WS_BIG + (size_t)MT * PW * 4;
constexpr size_t WS_MQ = WS_U + (size_t)MT * 512 * 4;
constexpr size_t WS_MK = WS_MQ + (size_t)MT * 768 * 2;
constexpr size_t WS_MVT = WS_MK + (size_t)MT * 768 * 2;
constexpr size_t WS_DQ = WS_MVT + (size_t)MT * 768 * 2;
constexpr size_t WS_DK = WS_DQ + (size_t)MT * 768 * 2;
constexpr size_t WS_DVT = WS_DK + (size_t)MT * 768 * 2;
constexpr size_t WS_YCAT = WS_DVT + (size_t)MT * 768 * 2;
constexpr size_t WS_KPART = WS_YCAT + (size_t)MT * DM * 2;
constexpr size_t WS_MEMH = WS_KPART + (size_t)4 * 64 * 768 * 4;
constexpr size_t WS_MEMKV = WS_MEMH + (size_t)2 * 1024 * DM * 2;
constexpr size_t WS_MEMK = WS_MEMKV + (size_t)2 * 1024 * 1024 * 4;
constexpr size_t WS_MEMVT = WS_MEMK + (size_t)2 * 1024 * 512 * 2;
constexpr size_t WS_OMEM = WS_MEMVT + (size_t)2 * 1024 * 512 * 2;
constexpr size_t WS_CNT = WS_OMEM + (size_t)MT * 512 * 2;
constexpr size_t WS_PSS = WS_CNT + 256;
constexpr size_t WS_END = WS_PSS + (size_t)MT * 32 * 4;

struct Params {
    const float* in[31];
    float* out;
    unsigned char* ws;
    int ph_lo, ph_hi;
};

__device__ __forceinline__ int otid() { int t = threadIdx.x; asm volatile("" : "+v"(t)); return t; }
namespace pg8 {
constexpr int BM = 256, BK = 64, HALF = 128, HTB = HALF * BK * 2, STAGE_BYTES = 8 * HTB, NXCD = 8, WGM = 8;
__host__ __device__ __forceinline__ int lds_byte(int r, int c) { const int st = (r >> 4) * 2 + (c >> 5), rr = r & 15, cc = c & 31, ob = rr * 64 + cc * 2; return st * 1024 + (ob ^ (((ob >> 9) & 1) << 5)); }
__host__ __device__ __forceinline__ void stage_rc(int b, int& R, int& C) { const int st = b / 1024, sb = b % 1024, swz = sb ^ (((sb >> 9) & 1) << 5); R = (st >> 1) * 16 + swz / 64; C = (st & 1) * 32 + (swz % 64) / 2; }
__host__ __device__ __forceinline__ int perm32(int rho) { const int n = rho >> 4, i = rho & 15; return 8 * (i >> 2) + 4 * n + (i & 3); }
struct Unit { int pm, pn; };
struct Gemm { const hf* A; const hf* Bt; int M, N, K; };
struct StaticOrder {
    int nM, nN, nwg, G, c;
    __device__ __forceinline__ void init(int M, int N, int G_, int c_) { nM = M / BM; nN = N / BM; nwg = nM * nN; G = G_; c = c_; }
    __device__ __forceinline__ bool next(int i, Unit& u) const {
        const long L = (long)i * G + c; if (L >= nwg) return false;
        int wgid = (int)L; { const int q = nwg / NXCD, r = nwg % NXCD, xcd = wgid % NXCD, off = wgid / NXCD; wgid = (xcd < r ? xcd * (q + 1) : r * (q + 1) + (xcd - r) * q) + off; }
        const int nig = WGM * nN, gid = wgid / nig, fm = gid * WGM, gsz = (nM - fm) < WGM ? (nM - fm) : WGM;
        u.pm = fm + ((wgid % nig) % gsz); u.pn = (wgid % nig) / gsz; return true;
    }
};
struct EpiF32 {
    static constexpr bool PERM = false;
    float* C; int ldc; LAS const float* rs;
    __device__ __forceinline__ void operator()(const f32x4 (&acc)[2][2][4][2], const Unit& u, int ui, int wr, int wc, int fr, int fq) const {
        const int row0 = u.pm * BM + wr * 64 + fr, col0 = u.pn * BM + wc * 32 + 4 * fq;
#pragma unroll
        for (int ai = 0; ai < 2; ++ai)
#pragma unroll
            for (int m = 0; m < 4; ++m) { float* rowp = C + (size_t)(row0 + ai * HALF + m * 16) * ldc + col0; const float sc = rs ? rs[ui * 256 + wr * 64 + fr + ai * HALF + m * 16] : 1.0f;
#pragma unroll
                for (int bj = 0; bj < 2; ++bj)
#pragma unroll
                    for (int n = 0; n < 2; ++n) *(f32x4*)(rowp + bj * HALF + n * 16) = acc[ai][bj][m][n] * sc; }
    }
};
struct EpiRes {
    static constexpr bool PERM = true;
    const float* base; float* out; const float* gn; hf* xg; float* pss; int ldc; float scale;
    __device__ __forceinline__ void operator()(const f32x4 (&acc)[2][2][4][2], const Unit& u, int ui, int wr, int wc, int fr, int fq) const {
        const int row0 = u.pm * BM + wr * 64 + fr, col0 = u.pn * BM + wc * 32 + 8 * fq;
        f32x4 gg[2][2];
#pragma unroll
        for (int bj = 0; bj < 2; ++bj)
#pragma unroll
            for (int n = 0; n < 2; ++n) gg[bj][n] = gn ? *(const f32x4*)(gn + col0 + bj * HALF + n * 4) : (f32x4){0.f, 0.f, 0.f, 0.f};
#pragma unroll
        for (int ai = 0; ai < 2; ++ai)
#pragma unroll
            for (int mp = 0; mp < 2; ++mp) {
                f32x4 b[2][2][2];
#pragma unroll
                for (int mm = 0; mm < 2; ++mm) { const size_t off = (size_t)(row0 + ai * HALF + (mp * 2 + mm) * 16) * ldc + col0;
#pragma unroll
                    for (int bj = 0; bj < 2; ++bj)
#pragma unroll
                        for (int n = 0; n < 2; ++n) b[mm][bj][n] = *(const f32x4*)(base + off + bj * HALF + n * 4); }
                __builtin_amdgcn_sched_barrier(0);
#pragma unroll
                for (int mm = 0; mm < 2; ++mm) { const int m = mp * 2 + mm, row = row0 + ai * HALF + m * 16; const size_t off = (size_t)row * ldc + col0; float ss = 0.f;
#pragma unroll
                    for (int bj = 0; bj < 2; ++bj) { h8 w;
#pragma unroll
                        for (int n = 0; n < 2; ++n) { const f32x4 o = b[mm][bj][n] + acc[ai][bj][m][n] * scale; *(f32x4*)(out + off + bj * HALF + n * 4) = o;
#pragma unroll
                            for (int j = 0; j < 4; ++j) { w[n * 4 + j] = (hf)(o[j] * gg[bj][n][j]); ss += o[j] * o[j]; } }
                        if (gn) *(h8*)(xg + off + bj * HALF) = w; }
                    if (gn) { ss += __shfl_xor(ss, 16); ss += __shfl_xor(ss, 32); if (fq == 0) pss[(size_t)row * 32 + u.pn * 4 + wc] = ss; } }
                __builtin_amdgcn_sched_barrier(0);
            }
    }
};
struct EpiH16 {
    static constexpr bool PERM = true;
    hf* C; int ldc; LAS const float* rs;
    __device__ __forceinline__ void operator()(const f32x4 (&acc)[2][2][4][2], const Unit& u, int ui, int wr, int wc, int fr, int fq) const {
        const int row0 = u.pm * BM + wr * 64 + fr, col0 = u.pn * BM + wc * 32 + 8 * fq;
#pragma unroll
        for (int ai = 0; ai < 2; ++ai)
#pragma unroll
            for (int m = 0; m < 4; ++m) { hf* rowp = C + (size_t)(row0 + ai * HALF + m * 16) * ldc + col0; const float sc = rs[ui * 256 + wr * 64 + fr + ai * HALF + m * 16];
#pragma unroll
                for (int bj = 0; bj < 2; ++bj) { h8 w;
#pragma unroll
                    for (int n = 0; n < 2; ++n)
#pragma unroll
                        for (int j = 0; j < 4; ++j) w[n * 4 + j] = (hf)(acc[ai][bj][m][n][j] * sc);
                    *(h8*)(rowp + bj * HALF) = w; } }
    }
};
struct EpiSwiGLU {
    static constexpr bool PERM = true;
    hf* O; int ldc; LAS const float* rs;
    __device__ __forceinline__ void operator()(const f32x4 (&acc)[2][2][4][2], const Unit& u, int ui, int wr, int wc, int fr, int fq) const {
        const int row0 = u.pm * BM + wr * 64 + fr, col0 = u.pn * HALF + wc * 32 + 8 * fq;
#pragma unroll
        for (int ai = 0; ai < 2; ++ai)
#pragma unroll
            for (int m = 0; m < 4; ++m) { hf* rowp = O + (size_t)(row0 + ai * HALF + m * 16) * ldc + col0; h8 w; const float sc = rs[ui * 256 + wr * 64 + fr + ai * HALF + m * 16];
#pragma unroll
                for (int n = 0; n < 2; ++n)
#pragma unroll
                    for (int j = 0; j < 4; ++j) { const float g = acc[ai][0][m][n][j] * sc, up = acc[ai][1][m][n][j] * sc; const float sg = g * __builtin_amdgcn_rcpf(1.0f + __expf(-g)); w[n * 4 + j] = (hf)(sg * up); }
                *(h8*)rowp = w; }
    }
};
template <class Sched>
__device__ __forceinline__ void fill_rs(LAS float* RS, const float* pss, const Sched& S) {
    const int tid = otid(); const int r = tid >> 1, hh = tid & 1;
    f32x4 v[6][4]; unsigned okm = 0u;
#pragma unroll
    for (int ui = 0; ui < 6; ++ui) { Unit u; u.pm = 0; u.pn = 0; const bool ok = S.next(ui, u); okm |= ok ? (1u << ui) : 0u;
        const float* pp = pss + (size_t)((ok ? u.pm : 0) * BM + r) * 32 + hh * 16;
#pragma unroll
        for (int e = 0; e < 4; ++e) v[ui][e] = *(const f32x4*)(pp + e * 4); }
#pragma unroll
    for (int ui = 0; ui < 6; ++ui) { float a = 0.f;
#pragma unroll
        for (int e = 0; e < 4; ++e) a += (v[ui][e][0] + v[ui][e][1]) + (v[ui][e][2] + v[ui][e][3]);
        a += __shfl_xor(a, 1);
        if (hh == 0 && ((okm >> ui) & 1u)) RS[ui * 256 + r] = rsqrtf(a * (1.0f / DM) + 1e-6f); }
    __syncthreads();
}
template <class Epi, class Sched>
__device__ __forceinline__ void gemm_phase(LAS unsigned char* lds, const Gemm g, const Sched& S, const Epi& E) {
    int tid = threadIdx.x; asm volatile("" : "+v"(tid));
    const int wid = __builtin_amdgcn_readfirstlane(tid >> 6), lane = tid & 63, wr = wid >> 2, wc = wid & 3, fr = lane & 15, fq = lane >> 4;
    const int K = g.K, nt = K / BK;
    unsigned voffA[2], voffB[2];
#pragma unroll
    for (int i = 0; i < 2; ++i) { int R, C; stage_rc(tid * 16 + i * 8192, R, C); const int Rb = Epi::PERM ? ((R & ~31) + perm32(R & 31)) : R;
        voffA[i] = (unsigned)(R * K + C) * 2u; voffB[i] = (unsigned)(Rb * K + C) * 2u; }
    const size_t kstep = (size_t)(BK * 2);
    const size_t hstep = (size_t)HALF * K * 2;
    const size_t tstep = 2 * hstep;
    const unsigned ldsw = (unsigned)wid * 1024u;
    const int aoff = lds_byte(wr * 64 + fr, fq * 8), boff = lds_byte(wc * 32 + fr, fq * 8);
#define PG8_SA(b, h) (((b) * 2 + (h)) * HTB)
#define PG8_SB(b, h) ((4 + (b) * 2 + (h)) * HTB)
#define PG8_STAGE(bufoff, gbase, voff) do { _Pragma("unroll") for (int _i = 0; _i < 2; ++_i) \
        __builtin_amdgcn_global_load_lds((const unsigned*)((const char*)(gbase) + (voff)[_i]), (LAS unsigned*)(lds + (bufoff) + ldsw + _i * 8192), 16, 0, 0); } while (0)
#define PG8_LDA(dst, b, h) do { _Pragma("unroll") for (int m = 0; m < 4; ++m) _Pragma("unroll") for (int k = 0; k < 2; ++k) dst[m][k] = *(const LAS h8*)(lds + PG8_SA(b, h) + aoff + m * 2048 + k * 1024); } while (0)
#define PG8_LDB(dst, b, h) do { _Pragma("unroll") for (int n = 0; n < 2; ++n) _Pragma("unroll") for (int k = 0; k < 2; ++k) dst[n][k] = *(const LAS h8*)(lds + PG8_SB(b, h) + boff + n * 2048 + k * 1024); } while (0)
#define PG8_MMA(ai, bj, At, Bt) do { __builtin_amdgcn_s_setprio(1); _Pragma("unroll") for (int m = 0; m < 4; ++m) _Pragma("unroll") for (int n = 0; n < 2; ++n) _Pragma("unroll") for (int k = 0; k < 2; ++k) \
        acc[ai][bj][m][n] = __builtin_amdgcn_mfma_f32_16x16x32_f16(Bt[n][k], At[m][k], acc[ai][bj][m][n], 0, 0, 0); __builtin_amdgcn_s_setprio(0); } while (0)
#define PG8_WAIT_V(n) asm volatile("s_waitcnt vmcnt(" #n ")" ::: "memory")
#define PG8_WAIT_L(n) asm volatile("s_waitcnt lgkmcnt(" #n ")" ::: "memory")
#define PG8_BAR __builtin_amdgcn_s_barrier()
#define PG8_SCHED __builtin_amdgcn_sched_barrier(0)
    Unit cur, nxt; int ui = 0;
    if (!S.next(0, cur)) return;
    f32x4 acc[2][2][4][2];
#pragma unroll
    for (int a = 0; a < 2; ++a)
#pragma unroll
        for (int b = 0; b < 2; ++b)
#pragma unroll
            for (int m = 0; m < 4; ++m)
#pragma unroll
                for (int n = 0; n < 2; ++n) acc[a][b][m][n] = (f32x4){0.f, 0.f, 0.f, 0.f};
    h8 At[4][2], B0[2][2], B1[2][2];
    const char* cA = (const char*)g.A + (size_t)cur.pm * tstep; const char* cB = (const char*)g.Bt + (size_t)cur.pn * tstep;
    PG8_STAGE(PG8_SB(0, 0), cB, voffB); PG8_STAGE(PG8_SB(0, 1), cB + hstep, voffB); PG8_STAGE(PG8_SA(0, 0), cA, voffA); PG8_STAGE(PG8_SA(0, 1), cA + hstep, voffA);
    if (wr == 1) PG8_BAR;
    PG8_WAIT_V(2); PG8_BAR;
    PG8_STAGE(PG8_SB(1, 0), cB + kstep, voffB); PG8_STAGE(PG8_SA(1, 0), cA + kstep, voffA); PG8_STAGE(PG8_SB(1, 1), cB + hstep + kstep, voffB);
    PG8_WAIT_V(6); PG8_BAR;
    for (;;) {
        const bool has_next = S.next(ui + 1, nxt);
        const char* nA = has_next ? (const char*)g.A + (size_t)nxt.pm * tstep : cA; const char* nB = has_next ? (const char*)g.Bt + (size_t)nxt.pn * tstep : cB;
        for (int t = 0; t < nt; t += 2) {
            const bool last = (t == nt - 2);
            const char* a1 = cA + (size_t)(t + 1) * kstep;
            const char* a2 = last ? nA : cA + (size_t)(t + 2) * kstep; const char* b2 = last ? nB : cB + (size_t)(t + 2) * kstep;
            const char* a3 = a2 + kstep; const char* b3 = b2 + kstep;
            PG8_LDB(B0, 0, 0); PG8_LDB(B1, 0, 1); PG8_SCHED; PG8_LDA(At, 0, 0); PG8_STAGE(PG8_SA(1, 1), a1 + hstep, voffA);
            PG8_WAIT_V(8); PG8_WAIT_L(0); PG8_BAR; PG8_MMA(0, 0, At, B0); PG8_MMA(0, 1, At, B1); PG8_BAR; PG8_SCHED;
            PG8_LDA(At, 0, 1); PG8_STAGE(PG8_SB(0, 0), b2, voffB); PG8_STAGE(PG8_SB(0, 1), b2 + hstep, voffB); PG8_STAGE(PG8_SA(0, 0), a2, voffA);
            PG8_WAIT_V(8); PG8_WAIT_L(0); PG8_BAR; PG8_MMA(1, 0, At, B0); PG8_MMA(1, 1, At, B1); PG8_BAR; PG8_SCHED;
            PG8_LDB(B0, 1, 0); PG8_LDB(B1, 1, 1); PG8_SCHED; PG8_LDA(At, 1, 0); PG8_STAGE(PG8_SA(0, 1), a2 + hstep, voffA);
            PG8_WAIT_V(8); PG8_WAIT_L(0); PG8_BAR; PG8_MMA(0, 0, At, B0); PG8_MMA(0, 1, At, B1); PG8_BAR; PG8_SCHED;
            PG8_LDA(At, 1, 1); PG8_STAGE(PG8_SB(1, 0), b3, voffB); PG8_STAGE(PG8_SB(1, 1), b3 + hstep, voffB); PG8_STAGE(PG8_SA(1, 0), a3, voffA);
            PG8_WAIT_V(8); PG8_WAIT_L(0); PG8_BAR; PG8_MMA(1, 0, At, B0); PG8_MMA(1, 1, At, B1); PG8_BAR; PG8_SCHED;
        }
        if (wr == 0) PG8_BAR;
        E(acc, cur, ui, wr, wc, fr, fq);
        if (!has_next) break;
#pragma unroll
        for (int a = 0; a < 2; ++a)
#pragma unroll
            for (int b = 0; b < 2; ++b)
#pragma unroll
                for (int m = 0; m < 4; ++m)
#pragma unroll
                    for (int n = 0; n < 2; ++n) acc[a][b][m][n] = (f32x4){0.f, 0.f, 0.f, 0.f};
        cur = nxt; cA = nA; cB = nB; ++ui;
        if (wr == 1) PG8_BAR;
    }
    PG8_WAIT_V(0);
    PG8_BAR;
#undef PG8_SA
#undef PG8_SB
#undef PG8_STAGE
#undef PG8_LDA
#undef PG8_LDB
#undef PG8_MMA
#undef PG8_WAIT_V
#undef PG8_WAIT_L
#undef PG8_BAR
#undef PG8_SCHED
}
}

__device__ __forceinline__ float wave_sum(float v) {
#pragma unroll
    for (int o = 32; o >= 1; o >>= 1) v += __shfl_xor(v, o);
    return v;
}
__device__ __forceinline__ float sigmoidf_(float x) { return 1.0f / (1.0f + __expf(-x)); }

struct ConvJob { const float* src; hf* dst; int K, N, mode; };
constexpr int NQJ = 20;
constexpr int QT_TOTAL = 9472;
__device__ __forceinline__ ConvJob get_job(const Params& P, int l, int j) {
    hf* wb = (hf*)(P.ws + WS_W) + (size_t)l * E_LAYER;
    ConvJob r;
    switch (j) {
    case 0: r = {P.in[4] + (size_t)l * DM * DFF, wb + O_GU1, DM, DFF, 1}; break;
    case 1: r = {P.in[5] + (size_t)l * DM * DFF, wb + O_GU1, DM, DFF, 2}; break;
    case 2: r = {P.in[6] + (size_t)l * DFF * DM, wb + O_DN1, DFF, DM, 0}; break;
    case 3: r = {P.in[8] + (size_t)l * DM * PW, wb + O_WIN, DM, PW, 0}; break;
    case 4: r = {P.in[19] + (size_t)l * DM * DM, wb + O_WOUT, DM, DM, 0}; break;
    case 5: r = {P.in[22] + (size_t)l * DM * 512, wb + O_WQ, DM, 512, 0}; break;
    case 6: r = {P.in[23] + (size_t)l * DM * 1024, wb + O_WKV, DM, 1024, 0}; break;
    case 7: r = {P.in[26] + (size_t)l * 512 * DM, wb + O_WO, 512, DM, 0}; break;
    case 8: r = {P.in[28] + (size_t)l * DM * DFF, wb + O_GU2, DM, DFF, 1}; break;
    case 9: r = {P.in[29] + (size_t)l * DM * DFF, wb + O_GU2, DM, DFF, 2}; break;
    default: r = {P.in[30] + (size_t)l * DFF * DM, wb + O_DN2, DFF, DM, 0}; break;
    }
    return r;
}
__device__ __forceinline__ void convert_tile(const ConvJob jb, int r, LAS unsigned char* lds) {
    const int tid = otid();
    LAS unsigned* T = (LAS unsigned*)lds;
    const int ntn = jb.N >> 8, tn = r % ntn, tk = r / ntn, n0 = tn * 256, k0 = tk * 64;
    const int n4 = (tid & 63) * 4, kr = tid >> 6;
    f32x4 v[8];
#pragma unroll
    for (int p = 0; p < 8; ++p) v[p] = *(const f32x4*)(jb.src + (size_t)(k0 + 2 * (kr + 8 * (p >> 1)) + (p & 1)) * jb.N + n0 + n4);
#pragma unroll
    for (int p = 0; p < 4; ++p) { const int k2 = kr + 8 * p; typedef unsigned u32x4 __attribute__((ext_vector_type(4))); u32x4 w;
#pragma unroll
        for (int e = 0; e < 4; ++e) { typedef _Float16 h2 __attribute__((ext_vector_type(2))); h2 t; t[0] = (hf)v[2 * p][e]; t[1] = (hf)v[2 * p + 1][e]; w[e] = __builtin_bit_cast(unsigned, t); }
        *(LAS u32x4*)(T + k2 * 260 + n4) = w; }
    __syncthreads();
    { const int n = tid & 255, hh = tid >> 8; const int gn = n0 + n;
      const int row = jb.mode == 0 ? gn : ((gn >> 7) * 256 + (gn & 127) + (jb.mode == 2 ? 128 : 0));
      hf* dp = jb.dst + (size_t)row * jb.K + k0 + hh * 32;
#pragma unroll
      for (int c = 0; c < 4; ++c) { typedef unsigned u32x4 __attribute__((ext_vector_type(4))); u32x4 w;
#pragma unroll
          for (int e = 0; e < 4; ++e) w[e] = T[(hh * 16 + c * 4 + e) * 260 + n];
          *(u32x4*)(dp + c * 8) = w; } }
    __syncthreads();
}
__device__ __forceinline__ void queue_tile(const Params& P, int slot, LAS unsigned char* lds) {
    constexpr int QL[NQJ] = {0, 0, 1, 0, 0, 0, 0, 0, 0, 0, 1, 1, 1, 1, 1, 1, 1, 1, 1, 1};
    constexpr int QJ[NQJ] = {2, 6, 6, 3, 4, 5, 7, 8, 9, 10, 0, 1, 2, 3, 4, 5, 7, 8, 9, 10};
    constexpr int QN[NQJ] = {704, 128, 128, 704, 256, 64, 64, 704, 704, 704, 704, 704, 704, 704, 256, 64, 64, 704, 704, 704};
    int r = slot, q = 0;
#pragma unroll
    for (int t = 0; t < NQJ - 1; ++t) { if (q == t && r >= QN[t]) { r -= QN[t]; q = t + 1; } }
    int l = 0, j = 0;
#pragma unroll
    for (int t = 0; t < NQJ; ++t) { if (q == t) { l = QL[t]; j = QJ[t]; } }
    convert_tile(get_job(P, l, j), r, lds);
}
__device__ __forceinline__ void conv_pull(const Params& P, LAS unsigned char* lds, int req, int quota) {
    constexpr int CL = 4;
    LAS int* misc = (LAS int*)(lds + 115968);
    int* q = (int*)(P.ws + WS_CNT) + 32;
    for (int n = 0;; n += CL) {
        __syncthreads();
        if (threadIdx.x == 0) { const int cur = __hip_atomic_load(q, __ATOMIC_RELAXED, __HIP_MEMORY_SCOPE_AGENT); int slot = -1;
            if (cur < QT_TOTAL && (cur < req || n < quota)) slot = atomicAdd(q, CL);
            misc[0] = slot; }
        __syncthreads();
        const int slot = misc[0];
        if (slot < 0 || slot >= QT_TOTAL) break;
        for (int k = 0; k < CL; ++k) if (slot + k < QT_TOTAL) queue_tile(P, slot + k, lds);
    }
}
__device__ __forceinline__ void convert_static(const Params& P, LAS unsigned char* lds, int bid, int nb) {
    for (int idx = bid; idx < 1408; idx += nb) { const int j = idx >= 704; convert_tile(get_job(P, 0, j), idx - j * 704, lds); }
}

__device__ __forceinline__ void norm_rows(const float* __restrict__ src, const float* __restrict__ g, hf* __restrict__ dst, int nrows, int bid, int nb, float* pss = nullptr) {
    const int tid = otid(), wid = tid >> 6, lane = tid & 63;
    for (int row = bid * 8 + wid; row < nrows; row += nb * 8) {
        const float* rp = src + (size_t)row * DM; f32x4 v[8]; float ss = 0.f;
#pragma unroll
        for (int e = 0; e < 8; ++e) { v[e] = *(const f32x4*)(rp + e * 256 + lane * 4); ss += v[e][0] * v[e][0] + v[e][1] * v[e][1] + v[e][2] * v[e][2] + v[e][3] * v[e][3]; }
        ss = wave_sum(ss); float r = rsqrtf(ss * (1.0f / DM) + 1e-6f);
        if (pss) { r = 1.0f; if (lane < 32) pss[(size_t)row * 32 + lane] = lane == 0 ? ss : 0.f; }
#pragma unroll
        for (int e = 0; e < 8; ++e) { const f32x4 gg = *(const f32x4*)(g + e * 256 + lane * 4); h4 w;
#pragma unroll
            for (int j = 0; j < 4; ++j) w[j] = (hf)(v[e][j] * r * gg[j]);
            *(h4*)(dst + (size_t)row * DM + e * 256 + lane * 4) = w; }
    }
}

__device__ __forceinline__ void memkv_post(const Params& P, int bid, int nb) {
    const int tid = otid(), wid = tid >> 6, lane = tid & 63;
    const float* KV = (const float*)(P.ws + WS_MEMKV); hf* MK = (hf*)(P.ws + WS_MEMK); hf* MVT = (hf*)(P.ws + WS_MEMVT);
    for (int row = bid * 8 + wid; row < 2048; row += nb * 8) {
        const int l = row >> 10, b = (row >> 8) & 3, m = row & 255; const float* rp = KV + (size_t)row * 1024;
        const float* kn = P.in[25] + l * 128;
#pragma unroll
        for (int c = 0; c < 2; ++c) {
            const f32x4 v = *(const f32x4*)(rp + c * 256 + lane * 4); float ss = v[0] * v[0] + v[1] * v[1] + v[2] * v[2] + v[3] * v[3];
#pragma unroll
            for (int o = 16; o >= 1; o >>= 1) ss += __shfl_xor(ss, o);
            const float r = rsqrtf(ss * (1.0f / 128) + 1e-6f); const int h = c * 2 + (lane >> 5), d = (lane & 31) * 4; const f32x4 gg = *(const f32x4*)(kn + d); h4 w;
#pragma unroll
            for (int j = 0; j < 4; ++j) w[j] = (hf)(v[j] * r * gg[j]);
            *(h4*)(MK + ((size_t)((l * 4 + b) * 4 + h) * 256 + m) * 128 + d) = w;
        }
#pragma unroll
        for (int c = 0; c < 2; ++c) {
            const f32x4 v = *(const f32x4*)(rp + 512 + c * 256 + lane * 4); const int h = c * 2 + (lane >> 5), d = (lane & 31) * 4;
#pragma unroll
            for (int j = 0; j < 4; ++j) MVT[((size_t)((l * 4 + b) * 4 + h) * 128 + d + j) * 256 + m] = (hf)v[j];
        }
    }
}

__device__ __forceinline__ f32x4 ldh4(const hf* p) { const h4 v = *(const h4*)p; return (f32x4){(float)v[0], (float)v[1], (float)v[2], (float)v[3]}; }
__device__ __forceinline__ f32x4 h4f(const h4 v) { return (f32x4){(float)v[0], (float)v[1], (float)v[2], (float)v[3]}; }
__device__ __forceinline__ void post_proj(const Params& P, int l, LAS unsigned char* lds, int bid, int nb) {
    const int tid = otid(), wid = tid >> 6, lane = tid & 63;
    const hf* PROJ = (const hf*)(P.ws + WS_BIG); float* U = (float*)(P.ws + WS_U);
    hf* MQ = (hf*)(P.ws + WS_MQ); hf* MK = (hf*)(P.ws + WS_MK); hf* MVT = (hf*)(P.ws + WS_MVT);
    hf* DQ = (hf*)(P.ws + WS_DQ); hf* DK = (hf*)(P.ws + WS_DK); hf* DVT = (hf*)(P.ws + WS_DVT); float* KPART = (float*)(P.ws + WS_KPART);
    const float* gmq = P.in[13] + l * 128; const float* gmk = P.in[14] + l * 128; const float* gdq = P.in[15] + l * 64; const float* gdk = P.in[16] + l * 64;
    LAS hf* T = (LAS hf*)lds;
    LAS float* KR = (LAS float*)(lds + 122880);
    const float sc_m = 0.08838834764831845f * LOG2E, sc_d = 0.125f * LOG2E;
    for (int item = bid; item < MT / 32; item += nb) {
        const int b = item >> 6, s0 = (item & 63) * 32;
        f32x4 ksum[3];
#pragma unroll
        for (int c = 0; c < 3; ++c) ksum[c] = (f32x4){0.f, 0.f, 0.f, 0.f};
        h4 rawn[22];
        { const hf* rp0 = PROJ + ((size_t)b * SQ + s0 + wid * 4) * PW;
#pragma unroll
          for (int c = 0; c < 22; ++c) rawn[c] = *(const h4*)(rp0 + c * 256 + lane * 4); }
        for (int it = 0; it < 4; ++it) {
            const int tl = wid * 4 + it, s = s0 + tl; const size_t tok = (size_t)b * SQ + s;
            h4 raw[22];
#pragma unroll
            for (int c = 0; c < 22; ++c) raw[c] = rawn[c];
            { const int itn = it < 3 ? it + 1 : 3; const hf* rpn = PROJ + ((size_t)b * SQ + s0 + wid * 4 + itn) * PW;
#pragma unroll
              for (int c = 0; c < 22; ++c) rawn[c] = *(const h4*)(rpn + c * 256 + lane * 4); }
            __builtin_amdgcn_sched_barrier(0);
#pragma unroll
            for (int c = 0; c < 2; ++c) { const f32x4 a = h4f(raw[c]), gg = h4f(raw[2 + c]); f32x4 u;
#pragma unroll
                for (int j = 0; j < 4; ++j) u[j] = a[j] * sigmoidf_(gg[j]);
                *(f32x4*)(U + tok * 512 + c * 256 + lane * 4) = u; }
#pragma unroll
            for (int c = 0; c < 3; ++c) {
                const int h = c * 2 + (lane >> 5), d = (lane & 31) * 4;
                { const f32x4 v = h4f(raw[4 + c]); float ss = v[0] * v[0] + v[1] * v[1] + v[2] * v[2] + v[3] * v[3];
#pragma unroll
                  for (int o = 16; o >= 1; o >>= 1) ss += __shfl_xor(ss, o);
                  const float r = rsqrtf(ss * (1.0f / 128) + 1e-6f) * sc_m; const f32x4 gg = *(const f32x4*)(gmq + d); h4 w;
#pragma unroll
                  for (int j = 0; j < 4; ++j) w[j] = (hf)(v[j] * r * gg[j]);
                  *(h4*)(MQ + ((size_t)(b * 6 + h) * SQ + s) * 128 + d) = w; }
                { const f32x4 v = h4f(raw[7 + c]); float ss = v[0] * v[0] + v[1] * v[1] + v[2] * v[2] + v[3] * v[3];
#pragma unroll
                  for (int o = 16; o >= 1; o >>= 1) ss += __shfl_xor(ss, o);
                  const float r = rsqrtf(ss * (1.0f / 128) + 1e-6f); const f32x4 gg = *(const f32x4*)(gmk + d); h4 w;
#pragma unroll
                  for (int j = 0; j < 4; ++j) { const float kn = v[j] * r * gg[j]; w[j] = (hf)kn; ksum[c][j] += kn; }
                  *(h4*)(MK + ((size_t)(b * 6 + h) * SQ + s) * 128 + d) = w; }
                { const f32x4 v = h4f(raw[10 + c]);
#pragma unroll
                  for (int j = 0; j < 4; ++j) T[(c * 256 + lane * 4 + j) * 40 + tl] = (hf)v[j]; }
            }
#pragma unroll
            for (int c = 0; c < 3; ++c) {
                const int hc = c * 4 + (lane >> 4), d = (lane & 15) * 4;
                { const f32x4 v = h4f(raw[13 + c]); float ss = v[0] * v[0] + v[1] * v[1] + v[2] * v[2] + v[3] * v[3];
#pragma unroll
                  for (int o = 8; o >= 1; o >>= 1) ss += __shfl_xor(ss, o);
                  const float r = rsqrtf(ss * (1.0f / 64) + 1e-6f) * sc_d; const f32x4 gg = *(const f32x4*)(gdq + d); h4 w;
#pragma unroll
                  for (int j = 0; j < 4; ++j) w[j] = (hf)(v[j] * r * gg[j]);
                  *(h4*)(DQ + ((size_t)(b * 12 + hc) * SQ + s) * 64 + d) = w; }
                { const f32x4 v = h4f(raw[16 + c]); float ss = v[0] * v[0] + v[1] * v[1] + v[2] * v[2] + v[3] * v[3];
#pragma unroll
                  for (int o = 8; o >= 1; o >>= 1) ss += __shfl_xor(ss, o);
                  const float r = rsqrtf(ss * (1.0f / 64) + 1e-6f); const f32x4 gg = *(const f32x4*)(gdk + d); h4 w;
#pragma unroll
                  for (int j = 0; j < 4; ++j) w[j] = (hf)(v[j] * r * gg[j]);
                  *(h4*)(DK + ((size_t)(b * 12 + hc) * SQ + s) * 64 + d) = w; }
                { const f32x4 v = h4f(raw[19 + c]);
#pragma unroll
                  for (int j = 0; j < 4; ++j) T[(768 + c * 256 + lane * 4 + j) * 40 + tl] = (hf)v[j]; }
            }
        }
#pragma unroll
        for (int c = 0; c < 3; ++c) *(LAS f32x4*)(KR + wid * 768 + c * 256 + lane * 4) = ksum[c];
        __syncthreads();
        for (int e = tid; e < 768; e += 512) { float a = 0.f;
#pragma unroll
            for (int w = 0; w < 8; ++w) a += KR[w * 768 + e];
            KPART[(size_t)item * 768 + e] = a; }
        for (int rr = tid; rr < 1536; rr += 512) {
            const int v2 = rr >= 768, r7 = rr - v2 * 768, h = r7 >> 7, d = r7 & 127; hf* dstp = (v2 ? DVT : MVT) + ((size_t)(b * 6 + h) * 128 + d) * SQ + s0;
#pragma unroll
            for (int q = 0; q < 4; ++q) *(h8*)(dstp + q * 8) = *(const LAS h8*)(T + rr * 40 + q * 8);
        }
        __syncthreads();
    }
}

__device__ __forceinline__ void conv_item(const Params& P, int l, LAS unsigned char* lds, int item) {
    const int tid = otid(), wid = tid >> 6, lane = tid & 63;
    const float* U = (const float*)(P.ws + WS_U); hf* Y = (hf*)(P.ws + WS_YCAT);
    const float* cw = P.in[9] + (size_t)l * CONVW * CONVC; const float* cb = P.in[10] + l * CONVC; const float* lg = P.in[11] + l * CONVC; const float* lb = P.in[12] + l * CONVC;
    const int b = item >> 7, s0 = (item & 127) * 16; const int ch = wid * 64 + lane;
    LAS float* UL = (LAS float*)lds;
    LAS float* ST = (LAS float*)(lds + 46 * 2048);
    float w[CONVW];
#pragma unroll
    for (int j = 0; j < CONVW; ++j) w[j] = cw[j * CONVC + ch];
    { f32x4 v[12];
#pragma unroll
      for (int k = 0; k < 12; ++k) { const int e = tid + 512 * k, r = e >> 7, c4 = (e & 127) * 4, s = s0 - 30 + r; const int sc = s < 0 ? 0 : s;
          v[k] = (e < 46 * 128) ? *(const f32x4*)(U + ((size_t)b * SQ + sc) * 512 + c4) : (f32x4){0.f, 0.f, 0.f, 0.f}; if (s < 0) v[k] = (f32x4){0.f, 0.f, 0.f, 0.f}; }
      __builtin_amdgcn_sched_barrier(0);
#pragma unroll
      for (int k = 0; k < 12; ++k) { const int e = tid + 512 * k, r = e >> 7, c4 = (e & 127) * 4; if (e < 46 * 128) *(LAS f32x4*)(UL + r * 512 + c4) = v[k]; } }
    __syncthreads();
    float u[46];
#pragma unroll
    for (int r = 0; r < 46; ++r) u[r] = UL[r * 512 + ch];
    const float bias = cb[ch]; float acc[16];
#pragma unroll
    for (int t = 0; t < 16; ++t) { float a = bias;
#pragma unroll
        for (int j = 0; j < CONVW; ++j) a += w[j] * u[t + j];
        acc[t] = a; }
#pragma unroll
    for (int t = 0; t < 16; ++t) { const float s1 = wave_sum(acc[t]), s2 = wave_sum(acc[t] * acc[t]); if (lane == 0) { ST[(wid * 16 + t) * 2] = s1; ST[(wid * 16 + t) * 2 + 1] = s2; } }
    __syncthreads();
    const float g = lg[ch], be = lb[ch];
#pragma unroll
    for (int t = 0; t < 16; ++t) { float s1 = 0.f, s2 = 0.f;
#pragma unroll
        for (int w8 = 0; w8 < 8; ++w8) { s1 += ST[(w8 * 16 + t) * 2]; s2 += ST[(w8 * 16 + t) * 2 + 1]; }
        const float mu = s1 * (1.0f / 512), var = fmaxf(s2 * (1.0f / 512) - mu * mu, 0.f), rstd = rsqrtf(var + 1e-5f);
        const float y = (acc[t] - mu) * rstd * g + be;
        Y[((size_t)b * SQ + s0 + t) * DM + ch] = (hf)(y * sigmoidf_(y)); }
}

constexpr int A_STG = 0, A_STG_BYTES = 35840, A_QS = 71680, A_LUT = 106496, A_TK0 = 107520, A_SELM = 107776, A_KM = 108288, A_GATE = 111872, A_MISC = 115968;
constexpr int VSTR = 144;
template <int DQK, bool CAUSAL, bool BIAS, bool SEL>
__device__ __forceinline__ void flash_tile(LAS const unsigned char* kb, LAS const float* lut, const h8 (&qf)[DQK / 32], int k0, int q0w, int qpos, int i, int g, unsigned selmask, f32x4 (&O)[8], float& mrow, float& lsum) {
    constexpr int KT_BYTES = DQK * 128, NKK = DQK / 32;
    const bool selok = SEL ? ((selmask >> (k0 >> 8)) & 1u) : true;
    const bool active = (!CAUSAL || k0 <= q0w + 15) && (!SEL || __ballot(selok) != 0ull);
    if (!active) return;
    LAS const unsigned char* vb = kb + KT_BYTES;
    f32x4 sa[4];
    { h8 kf[4][NKK];
#pragma unroll
      for (int st = 0; st < 4; ++st)
#pragma unroll
          for (int kk = 0; kk < NKK; ++kk) kf[st][kk] = *(const LAS h8*)(kb + (kk * 4 + g) * 1024 + (16 * st + i) * 16);
      __builtin_amdgcn_sched_barrier(0);
#pragma unroll
      for (int st = 0; st < 4; ++st) sa[st] = (f32x4){0.f, 0.f, 0.f, 0.f};
#pragma unroll
      for (int kk = 0; kk < NKK; ++kk)
#pragma unroll
          for (int st = 0; st < 4; ++st) sa[st] = __builtin_amdgcn_mfma_f32_16x16x32_f16(kf[st][kk], qf[kk], sa[st], 0, 0, 0); }
    h8 vf[8][2];
#pragma unroll
    for (int dt = 0; dt < 8; ++dt)
#pragma unroll
        for (int s2 = 0; s2 < 2; ++s2) vf[dt][s2] = *(const LAS h8*)(vb + (4 * s2 + g) * 2048 + (16 * dt + i) * 16);
    __builtin_amdgcn_sched_barrier(0);
    if (BIAS) {
        const bool far = (k0 + 63 + 128 <= q0w);
        if (far) { const float bc = lut[128];
#pragma unroll
            for (int st = 0; st < 4; ++st)
#pragma unroll
                for (int r = 0; r < 4; ++r) sa[st][r] += bc;
        } else {
            const int dbase = qpos - k0 - 8 * g; float bv[4][4];
#pragma unroll
            for (int st = 0; st < 4; ++st)
#pragma unroll
                for (int r = 0; r < 4; ++r) { const int dist = dbase - (32 * (st >> 1) + 4 * (st & 1) + r); const int dc = dist < 0 ? 0 : (dist > 128 ? 128 : dist); bv[st][r] = lut[dc]; }
#pragma unroll
            for (int st = 0; st < 4; ++st)
#pragma unroll
                for (int r = 0; r < 4; ++r) asm volatile("" : "+v"(bv[st][r]));
#pragma unroll
            for (int st = 0; st < 4; ++st)
#pragma unroll
                for (int r = 0; r < 4; ++r) { const int dist = dbase - (32 * (st >> 1) + 4 * (st & 1) + r); sa[st][r] = dist >= 0 ? sa[st][r] + bv[st][r] : NEGV; }
        }
    }
    if (SEL) { if (!selok) {
#pragma unroll
        for (int st = 0; st < 4; ++st)
#pragma unroll
            for (int r = 0; r < 4; ++r) sa[st][r] = NEGV; } }
    float mx = NEGV;
#pragma unroll
    for (int st = 0; st < 4; ++st)
#pragma unroll
        for (int r = 0; r < 4; ++r) mx = fmaxf(mx, sa[st][r]);
    mx = fmaxf(mx, __shfl_xor(mx, 16)); mx = fmaxf(mx, __shfl_xor(mx, 32));
    const float mnew = fmaxf(mrow, mx);
    const bool grow = mnew > mrow;
    float ps = 0.f; h8 pf[2];
#pragma unroll
    for (int st = 0; st < 4; ++st)
#pragma unroll
        for (int r = 0; r < 4; ++r) { const float p = __builtin_amdgcn_exp2f(sa[st][r] - mnew); ps += p; pf[st >> 1][(st & 1) * 4 + r] = (hf)p; }
    if (__ballot(grow) != 0ull) {
        const float alpha = __builtin_amdgcn_exp2f(mrow - mnew); lsum *= alpha;
#pragma unroll
        for (int dt = 0; dt < 8; ++dt) O[dt] *= alpha;
    }
    mrow = mnew; lsum += ps;
    __builtin_amdgcn_sched_barrier(0);
#pragma unroll
    for (int s2 = 0; s2 < 2; ++s2)
#pragma unroll
        for (int dt = 0; dt < 8; ++dt) O[dt] = __builtin_amdgcn_mfma_f32_16x16x32_f16(vf[dt][s2], pf[s2], O[dt], 0, 0, 0);
}
template <int DQK, bool CAUSAL, bool BIAS, bool QLDS, bool SEL>
__device__ __forceinline__ void flash_core(LAS unsigned char* lds, const hf* Qb, const hf* Kb, const hf* VTb, int vts, int q0, int ntiles, unsigned selmask, f32x4 (&O)[8], float& lsum) {
    constexpr int KT_BYTES = DQK * 128, NKK = DQK / 32, KCH = DQK / 64, C8M = DQK / 8 - 1, RSH = (DQK == 128) ? 7 : 6;
    int tid = threadIdx.x; asm volatile("" : "+v"(tid));
    const int wid = __builtin_amdgcn_readfirstlane(tid >> 6), lane = tid & 63, i = lane & 15, g = lane >> 4;
    const int q0w = q0 + wid * 16, qpos = q0w + i;
    LAS const int* tk0 = (LAS const int*)(lds + A_TK0); LAS const float* lut = (LAS const float*)(lds + A_LUT);
    h8 qf[NKK];
#pragma unroll
    for (int kk = 0; kk < NKK; ++kk) {
        if (QLDS) qf[kk] = *(const LAS h8*)(lds + A_QS + (wid * 16 + i) * 272 + kk * 64 + g * 16);
        else qf[kk] = *(const h8*)(Qb + (size_t)qpos * DQK + kk * 32 + g * 8);
    }
#pragma unroll
    for (int dt = 0; dt < 8; ++dt) O[dt] = (f32x4){0.f, 0.f, 0.f, 0.f};
    float mrow = NEGV; lsum = 0.f;
    h8 kA[KCH], vA[2], kB[KCH], vB[2];
#define FA_LOADG(kreg, vreg, k0_) do { _Pragma("unroll") for (int e = 0; e < KCH; ++e) { const int c = tid + 512 * e, row = ((c >> RSH) << 3) | (c & 7), c8 = (c >> 3) & C8M; kreg[e] = *(const h8*)(Kb + (size_t)((k0_) + row) * DQK + c8 * 8); } \
        _Pragma("unroll") for (int e = 0; e < 2; ++e) { const int c = tid + 512 * e, d = ((c >> 6) << 3) | (c & 7), k8 = (c >> 3) & 7; vreg[e] = *(const h8*)(VTb + (size_t)d * vts + (k0_) + k8 * 8); } } while (0)
#define FA_STORE(kreg, vreg, buf_) do { LAS unsigned char* sb = lds + A_STG + (buf_) * A_STG_BYTES; \
        _Pragma("unroll") for (int e = 0; e < KCH; ++e) { const int c = tid + 512 * e, row = ((c >> RSH) << 3) | (c & 7), c8 = (c >> 3) & C8M; const int p = (row & 32) | ((row & 4) << 2) | ((row & 24) >> 1) | (row & 3); *(LAS h8*)(sb + c8 * 1024 + p * 16) = kreg[e]; } \
        _Pragma("unroll") for (int e = 0; e < 2; ++e) { const int c = tid + 512 * e, d = ((c >> 6) << 3) | (c & 7), k8 = (c >> 3) & 7; *(LAS h8*)(sb + KT_BYTES + k8 * 2048 + d * 16) = vreg[e]; } } while (0)
    const int ntm1 = ntiles - 1;
#define FA_K0(t_) tk0[(t_) < ntm1 ? (t_) : ntm1]
    { const int k00 = FA_K0(0); FA_LOADG(kA, vA, k00); }
    { const int k01 = FA_K0(1); FA_LOADG(kB, vB, k01); }
    FA_STORE(kA, vA, 0);
    __syncthreads();
    for (int t = 0; t < ntiles; t += 2) {
        { const int kn = FA_K0(t + 2); FA_LOADG(kA, vA, kn); }
        flash_tile<DQK, CAUSAL, BIAS, SEL>(lds + A_STG, lut, qf, tk0[t], q0w, qpos, i, g, selmask, O, mrow, lsum);
        FA_STORE(kB, vB, 1);
        __syncthreads();
        { const int kn = FA_K0(t + 3); FA_LOADG(kB, vB, kn); }
        if (t + 1 < ntiles) flash_tile<DQK, CAUSAL, BIAS, SEL>(lds + A_STG + A_STG_BYTES, lut, qf, tk0[t + 1], q0w, qpos, i, g, selmask, O, mrow, lsum);
        FA_STORE(kA, vA, 0);
        __syncthreads();
    }
#undef FA_K0
#undef FA_LOADG
#undef FA_STORE
}
__device__ __forceinline__ float row_total(float l) { l += __shfl_xor(l, 16); l += __shfl_xor(l, 32); return l; }

__device__ __forceinline__ int t5_bucket(int dist) {
    if (dist < 16) return dist;
    const float lr = logf((float)dist / 16.0f) / 2.0794415416798357f;
    const int v = 16 + (int)(lr * 16.0f);
    return v < 31 ? v : 31;
}
__device__ __forceinline__ void fill_lut(LAS unsigned char* lds, const float* rel_bias, int hcol) {
    LAS float* lut = (LAS float*)(lds + A_LUT);
    for (int d = otid(); d <= 128; d += 512) lut[d] = rel_bias[t5_bucket(d) * 12 + hcol] * LOG2E;
}

constexpr int D_STG_BYTES = 32768, D_K2 = 8192, D_VT = 16384;
__device__ __forceinline__ void flash_tile_dual(LAS const unsigned char* sb, LAS const float* lut, const h8 (&qa)[2], const h8 (&qb)[2], int k0, int q0w, int qpos, int i, int g,
                                                f32x4 (&O1)[8], f32x4 (&O2)[8], float& m1, float& m2, float& l1, float& l2) {
    constexpr int KSTR = 144;
    if (k0 > q0w + 15) return;
    LAS const unsigned char* vb = sb + D_VT;
    f32x4 sa[4], sc[4];
    { h8 k1[4][2], k2[4][2];
#pragma unroll
      for (int st = 0; st < 4; ++st)
#pragma unroll
          for (int kk = 0; kk < 2; ++kk) { k1[st][kk] = *(const LAS h8*)(sb + (kk * 4 + g) * 1024 + (16 * st + i) * 16); k2[st][kk] = *(const LAS h8*)(sb + D_K2 + (kk * 4 + g) * 1024 + (16 * st + i) * 16); }
      __builtin_amdgcn_sched_barrier(0);
#pragma unroll
      for (int st = 0; st < 4; ++st) { sa[st] = (f32x4){0.f, 0.f, 0.f, 0.f}; sc[st] = (f32x4){0.f, 0.f, 0.f, 0.f}; }
#pragma unroll
      for (int kk = 0; kk < 2; ++kk)
#pragma unroll
          for (int st = 0; st < 4; ++st) { sa[st] = __builtin_amdgcn_mfma_f32_16x16x32_f16(k1[st][kk], qa[kk], sa[st], 0, 0, 0); sc[st] = __builtin_amdgcn_mfma_f32_16x16x32_f16(k2[st][kk], qb[kk], sc[st], 0, 0, 0); } }
    __builtin_amdgcn_sched_barrier(0);
    const bool far = (k0 + 63 + 128 <= q0w);
    if (far) { const float bc = lut[128];
#pragma unroll
        for (int st = 0; st < 4; ++st)
#pragma unroll
            for (int r = 0; r < 4; ++r) { sa[st][r] += bc; sc[st][r] += bc; }
    } else {
        const int dbase = qpos - k0 - 8 * g; float bv[4][4];
#pragma unroll
        for (int st = 0; st < 4; ++st)
#pragma unroll
            for (int r = 0; r < 4; ++r) { const int dist = dbase - (32 * (st >> 1) + 4 * (st & 1) + r); const int dc = dist < 0 ? 0 : (dist > 128 ? 128 : dist); bv[st][r] = lut[dc]; }
#pragma unroll
        for (int st = 0; st < 4; ++st)
#pragma unroll
            for (int r = 0; r < 4; ++r) asm volatile("" : "+v"(bv[st][r]));
#pragma unroll
        for (int st = 0; st < 4; ++st)
#pragma unroll
            for (int r = 0; r < 4; ++r) { const int dist = dbase - (32 * (st >> 1) + 4 * (st & 1) + r); sa[st][r] = dist >= 0 ? sa[st][r] + bv[st][r] : NEGV; sc[st][r] = dist >= 0 ? sc[st][r] + bv[st][r] : NEGV; }
    }
    float mx1 = NEGV, mx2 = NEGV;
#pragma unroll
    for (int st = 0; st < 4; ++st)
#pragma unroll
        for (int r = 0; r < 4; ++r) { mx1 = fmaxf(mx1, sa[st][r]); mx2 = fmaxf(mx2, sc[st][r]); }
    mx1 = fmaxf(mx1, __shfl_xor(mx1, 16)); mx1 = fmaxf(mx1, __shfl_xor(mx1, 32));
    mx2 = fmaxf(mx2, __shfl_xor(mx2, 16)); mx2 = fmaxf(mx2, __shfl_xor(mx2, 32));
    const float n1 = fmaxf(m1, mx1), n2 = fmaxf(m2, mx2);
    const bool grow = (n1 > m1) || (n2 > m2);
    float p1s = 0.f, p2s = 0.f; h8 pa[2], pb[2];
#pragma unroll
    for (int st = 0; st < 4; ++st)
#pragma unroll
        for (int r = 0; r < 4; ++r) { const float p1 = __builtin_amdgcn_exp2f(sa[st][r] - n1), p2 = __builtin_amdgcn_exp2f(sc[st][r] - n2); p1s += p1; p2s += p2;
            pa[st >> 1][(st & 1) * 4 + r] = (hf)p1; pb[st >> 1][(st & 1) * 4 + r] = (hf)p2; }
    if (__ballot(grow) != 0ull) {
        const float a1 = __builtin_amdgcn_exp2f(m1 - n1), a2 = __builtin_amdgcn_exp2f(m2 - n2); l1 *= a1; l2 *= a2;
#pragma unroll
        for (int dt = 0; dt < 8; ++dt) { O1[dt] *= a1; O2[dt] *= a2; }
    }
    m1 = n1; m2 = n2; l1 += p1s; l2 += p2s;
    __builtin_amdgcn_sched_barrier(0);
#pragma unroll
    for (int s2 = 0; s2 < 2; ++s2) { h8 vf[8];
#pragma unroll
        for (int dt = 0; dt < 8; ++dt) vf[dt] = *(const LAS h8*)(vb + (4 * s2 + g) * 2048 + (16 * dt + i) * 16);
        __builtin_amdgcn_sched_barrier(0);
#pragma unroll
        for (int dt = 0; dt < 8; ++dt) { O1[dt] = __builtin_amdgcn_mfma_f32_16x16x32_f16(vf[dt], pa[s2], O1[dt], 0, 0, 0); O2[dt] = __builtin_amdgcn_mfma_f32_16x16x32_f16(vf[dt], pb[s2], O2[dt], 0, 0, 0); }
        __builtin_amdgcn_sched_barrier(0); }
}
__device__ __forceinline__ void flash_core_dual(LAS unsigned char* lds, const hf* Q1, const hf* K1, const hf* Q2, const hf* K2, const hf* VTb, int q0, int ntiles,
                                                f32x4 (&O1)[8], f32x4 (&O2)[8], float& l1, float& l2) {
    constexpr int KSTR = 144;
    int tid = threadIdx.x; asm volatile("" : "+v"(tid));
    const int wid = __builtin_amdgcn_readfirstlane(tid >> 6), lane = tid & 63, i = lane & 15, g = lane >> 4;
    const int q0w = q0 + wid * 16, qpos = q0w + i;
    LAS const float* lut = (LAS const float*)(lds + A_LUT);
    h8 qa[2], qb[2];
#pragma unroll
    for (int kk = 0; kk < 2; ++kk) { qa[kk] = *(const h8*)(Q1 + (size_t)qpos * 64 + kk * 32 + g * 8); qb[kk] = *(const h8*)(Q2 + (size_t)qpos * 64 + kk * 32 + g * 8); }
#pragma unroll
    for (int dt = 0; dt < 8; ++dt) { O1[dt] = (f32x4){0.f, 0.f, 0.f, 0.f}; O2[dt] = (f32x4){0.f, 0.f, 0.f, 0.f}; }
    float m1 = NEGV, m2 = NEGV; l1 = 0.f; l2 = 0.f;
    h8 rA[4], rB[4];
    const int krow = ((tid >> 6) << 3) | (tid & 7), kc8 = (tid >> 3) & 7;
    const int kp = (krow & 32) | ((krow & 4) << 2) | ((krow & 24) >> 1) | (krow & 3);
#define FD_LOADG(r, k0_) do { r[0] = *(const h8*)(K1 + (size_t)((k0_) + krow) * 64 + kc8 * 8); r[1] = *(const h8*)(K2 + (size_t)((k0_) + krow) * 64 + kc8 * 8); \
        _Pragma("unroll") for (int e = 0; e < 2; ++e) { const int c = tid + 512 * e, d = ((c >> 6) << 3) | (c & 7), k8 = (c >> 3) & 7; r[2 + e] = *(const h8*)(VTb + (size_t)d * SQ + (k0_) + k8 * 8); } } while (0)
#define FD_STORE(r, buf_) do { LAS unsigned char* sb = lds + A_STG + (buf_) * D_STG_BYTES; *(LAS h8*)(sb + kc8 * 1024 + kp * 16) = r[0]; *(LAS h8*)(sb + D_K2 + kc8 * 1024 + kp * 16) = r[1]; \
        _Pragma("unroll") for (int e = 0; e < 2; ++e) { const int c = tid + 512 * e, d = ((c >> 6) << 3) | (c & 7), k8 = (c >> 3) & 7; *(LAS h8*)(sb + D_VT + k8 * 2048 + d * 16) = r[2 + e]; } } while (0)
    const int ntm1 = ntiles - 1;
#define FD_K0(t_) (64 * ((t_) < ntm1 ? (t_) : ntm1))
    FD_LOADG(rA, FD_K0(0)); FD_LOADG(rB, FD_K0(1));
    FD_STORE(rA, 0);
    __syncthreads();
    for (int t = 0; t < ntiles; t += 2) {
        FD_LOADG(rA, FD_K0(t + 2));
        flash_tile_dual(lds + A_STG, lut, qa, qb, 64 * t, q0w, qpos, i, g, O1, O2, m1, m2, l1, l2);
        FD_STORE(rB, 1);
        __syncthreads();
        FD_LOADG(rB, FD_K0(t + 3));
        if (t + 1 < ntiles) flash_tile_dual(lds + A_STG + D_STG_BYTES, lut, qa, qb, 64 * (t + 1), q0w, qpos, i, g, O1, O2, m1, m2, l1, l2);
        FD_STORE(rA, 0);
        __syncthreads();
    }
#undef FD_LOADG
#undef FD_STORE
#undef FD_K0
}

__device__ __forceinline__ void diff_item(const Params& P, int l, LAS unsigned char* lds, int bh, int qt) {
    const int tid = otid(), wid = __builtin_amdgcn_readfirstlane(tid >> 6), lane = tid & 63, i = lane & 15, g = lane >> 4;
    const int b = bh / 6, h = bh % 6, q0 = qt * 128;
    const hf* DQ = (const hf*)(P.ws + WS_DQ); const hf* DK = (const hf*)(P.ws + WS_DK); const hf* DVT = (const hf*)(P.ws + WS_DVT); hf* Y = (hf*)(P.ws + WS_YCAT);
    fill_lut(lds, P.in[2], 6 + h);
    const int ntiles = (q0 + 128) / 64;
    LAS int* tk0 = (LAS int*)(lds + A_TK0);
    if (tid < ntiles) tk0[tid] = tid * 64;
    const float* lp = P.in[17] + l * 256;
    const float s1 = wave_sum(lp[lane] * lp[64 + lane]), s2 = wave_sum(lp[128 + lane] * lp[192 + lane]);
    const float lam_init = 0.8f - 0.6f * expf(-0.3f * (float)l);
    const float lam = expf(s1) - expf(s2) + lam_init;
    __syncthreads();
    const hf* VT = DVT + (size_t)(b * 6 + h) * 128 * SQ;
    f32x4 O1[8], O2[8]; float l1, l2;
    flash_core_dual(lds, DQ + (size_t)((b * 6 + h) * 2 + 0) * SQ * 64, DK + (size_t)((b * 6 + h) * 2 + 0) * SQ * 64, DQ + (size_t)((b * 6 + h) * 2 + 1) * SQ * 64, DK + (size_t)((b * 6 + h) * 2 + 1) * SQ * 64, VT, q0, ntiles, O1, O2, l1, l2);
    { const float inv = 1.0f / row_total(l1);
#pragma unroll
      for (int dt = 0; dt < 8; ++dt) O1[dt] *= inv; }
    const float inv2 = lam / row_total(l2); float ss = 0.f;
#pragma unroll
    for (int dt = 0; dt < 8; ++dt) { O1[dt] -= O2[dt] * inv2; ss += O1[dt][0] * O1[dt][0] + O1[dt][1] * O1[dt][1] + O1[dt][2] * O1[dt][2] + O1[dt][3] * O1[dt][3]; }
    ss = row_total(ss);
    const float r = rsqrtf(ss * (1.0f / 128) + 1e-6f) * (1.0f - lam_init);
    const float* sg = P.in[18] + l * 128;
    hf* yp = Y + ((size_t)b * SQ + q0 + wid * 16 + i) * DM + 1280 + h * 128;
    f32x4 gg8[8];
#pragma unroll
    for (int dt = 0; dt < 8; ++dt) gg8[dt] = *(const f32x4*)(sg + dt * 16 + g * 4);
#pragma unroll
    for (int dt = 0; dt < 8; ++dt) { h4 w;
#pragma unroll
        for (int j = 0; j < 4; ++j) w[j] = (hf)(O1[dt][j] * r * gg8[dt][j]);
        *(h4*)(yp + dt * 16 + g * 4) = w; }
}

__device__ __forceinline__ void moba_item(const Params& P, int l, LAS unsigned char* lds, int bh, int qt) {
    const int tid = otid(), wid = __builtin_amdgcn_readfirstlane(tid >> 6), lane = tid & 63, i = lane & 15, g = lane >> 4;
    const int b = bh / 6, h = bh % 6, q0 = qt * 128, cur = q0 >> 8;
    const hf* MQ = (const hf*)(P.ws + WS_MQ) + (size_t)(b * 6 + h) * SQ * 128; const hf* MK = (const hf*)(P.ws + WS_MK) + (size_t)(b * 6 + h) * SQ * 128;
    const hf* MVT = (const hf*)(P.ws + WS_MVT) + (size_t)(b * 6 + h) * 128 * SQ; const float* KPART = (const float*)(P.ws + WS_KPART); hf* Y = (hf*)(P.ws + WS_YCAT);
    fill_lut(lds, P.in[2], h);
    LAS int* tk0 = (LAS int*)(lds + A_TK0); LAS unsigned* selm = (LAS unsigned*)(lds + A_SELM); LAS float* KM = (LAS float*)(lds + A_KM); LAS float* GT = (LAS float*)(lds + A_GATE);
    LAS unsigned* misc = (LAS unsigned*)(lds + A_MISC);
    for (int e = tid; e < cur * 128; e += 512) { const int j = e >> 7, d = e & 127; float a = 0.f;
#pragma unroll
        for (int c = 0; c < 8; ++c) a += KPART[((size_t)b * 64 + j * 8 + c) * 768 + h * 128 + d];
        KM[e] = a * (1.0f / 256); }
    if (tid == 0) misc[1] = 0u;
    __syncthreads();
    {
        const int r = tid >> 2, jj = tid & 3; const hf* qp = MQ + (size_t)(q0 + r) * 128; float g0 = 0.f, g1 = 0.f;
        if (jj < cur) {
            for (int hb = 0; hb < 4; ++hb) { h8 qv[4];
#pragma unroll
                for (int d8 = 0; d8 < 4; ++d8) qv[d8] = *(const h8*)(qp + (hb * 4 + d8) * 8);
                __builtin_amdgcn_sched_barrier(0);
#pragma unroll
                for (int d8 = 0; d8 < 4; ++d8) {
#pragma unroll
                    for (int e = 0; e < 8; ++e) { const float qx = (float)qv[d8][e]; g0 += qx * KM[jj * 128 + (hb * 4 + d8) * 8 + e]; if (jj + 4 < cur) g1 += qx * KM[(jj + 4) * 128 + (hb * 4 + d8) * 8 + e]; } } }
        }
        GT[r * 8 + jj] = g0; GT[r * 8 + jj + 4] = g1;
    }
    __syncthreads();
    if (tid < 128) {
        unsigned m = 0u;
        if (cur <= 3) m = (1u << cur) - 1u;
        else {
            for (int k = 0; k < 3; ++k) { float best = -3.0e38f; int bi = 0;
                for (int j = 0; j < cur; ++j) { const float v = GT[tid * 8 + j]; if (!((m >> j) & 1u) && v > best) { best = v; bi = j; } }
                m |= 1u << bi; }
        }
        selm[tid] = m | (1u << cur);
        atomicOr((unsigned*)&misc[1], m);
    }
    __syncthreads();
    const unsigned vis = misc[1];
    int ntiles = 0;
    {
        const int own_t = (q0 + 128 - cur * 256) / 64;
        if (tid == 0) { int n = 0; for (int t = 0; t < own_t; ++t) tk0[n++] = cur * 256 + t * 64; for (int j = 0; j < cur; ++j) if ((vis >> j) & 1u) for (int t = 0; t < 4; ++t) tk0[n++] = j * 256 + t * 64; }
        ntiles = own_t + 4 * __popc(vis);
    }
    __syncthreads();
    const unsigned mysel = selm[wid * 16 + i];
    f32x4 O[8]; float ls;
    flash_core<128, true, true, false, true>(lds, MQ, MK, MVT, SQ, q0, ntiles, mysel, O, ls);
    const float inv = 1.0f / row_total(ls);
    hf* yp = Y + ((size_t)b * SQ + q0 + wid * 16 + i) * DM + 512 + h * 128;
#pragma unroll
    for (int dt = 0; dt < 8; ++dt) { h4 w;
#pragma unroll
        for (int j = 0; j < 4; ++j) w[j] = (hf)(O[dt][j] * inv);
        *(h4*)(yp + dt * 16 + g * 4) = w; }
}

__device__ __forceinline__ void mem_item(const Params& P, int l, LAS unsigned char* lds, int item) {
    const int tid = otid(), wid = __builtin_amdgcn_readfirstlane(tid >> 6), lane = tid & 63, i = lane & 15, g = lane >> 4;
    const int qt = item & 15, h = (item >> 4) & 3, b = item >> 6, q0 = qt * 128;
    const float* QF = (const float*)(P.ws + WS_BIG); hf* OM = (hf*)(P.ws + WS_OMEM);
    const hf* K = (const hf*)(P.ws + WS_MEMK) + (size_t)((l * 4 + b) * 4 + h) * 256 * 128; const hf* VT = (const hf*)(P.ws + WS_MEMVT) + (size_t)((l * 4 + b) * 4 + h) * 128 * 256;
    LAS int* tk0 = (LAS int*)(lds + A_TK0);
    if (tid < 4) tk0[tid] = tid * 64;
    { const int r = tid >> 2, qq = tid & 3; const float* qp = QF + ((size_t)b * SQ + q0 + r) * 512 + h * 128 + qq * 32; f32x4 v[8]; float ss = 0.f;
#pragma unroll
      for (int e = 0; e < 8; ++e) { v[e] = *(const f32x4*)(qp + e * 4); ss += v[e][0] * v[e][0] + v[e][1] * v[e][1] + v[e][2] * v[e][2] + v[e][3] * v[e][3]; }
      ss += __shfl_xor(ss, 1); ss += __shfl_xor(ss, 2);
      const float rr = rsqrtf(ss * (1.0f / 128) + 1e-6f) * (0.08838834764831845f * LOG2E); const float* gq = P.in[24] + l * 128 + qq * 32;
#pragma unroll
      for (int e = 0; e < 8; ++e) { const f32x4 gg = *(const f32x4*)(gq + e * 4); h4 w;
#pragma unroll
          for (int j = 0; j < 4; ++j) w[j] = (hf)(v[e][j] * rr * gg[j]);
          *(LAS h4*)(lds + A_QS + r * 272 + (qq * 32 + e * 4) * 2) = w; } }
    __syncthreads();
    f32x4 O[8]; float ls;
    flash_core<128, false, false, true, false>(lds, nullptr, K, VT, 256, q0, 4, 0xffffffffu, O, ls);
    const float inv = 1.0f / row_total(ls);
    hf* yp = OM + ((size_t)b * SQ + q0 + wid * 16 + i) * 512 + h * 128;
#pragma unroll
    for (int dt = 0; dt < 8; ++dt) { h4 w;
#pragma unroll
        for (int j = 0; j < 4; ++j) w[j] = (hf)(O[dt][j] * inv);
        *(h4*)(yp + dt * 16 + g * 4) = w; }
}

__device__ __forceinline__ int next_item(LAS unsigned char* lds, int* cnt) {
    LAS int* misc = (LAS int*)(lds + A_MISC);
    __syncthreads();
    if (threadIdx.x == 0) misc[0] = atomicAdd(cnt, 1);
    __syncthreads();
    return misc[0];
}

__global__ void __launch_bounds__(512, 2) fwd_mega(Params P) {
    extern __shared__ __attribute__((aligned(16))) unsigned char smem[];
    LAS unsigned char* lds = (LAS unsigned char*)smem;
    cg::grid_group grid = cg::this_grid();
    const int bid = blockIdx.x, nb = gridDim.x;
    const int lo = P.ph_lo, hi = P.ph_hi;
    int ph = 0;
#ifndef TIMING_MASK
#define TIMING_MASK 0
#endif
#ifndef TIMING_AMP
#define TIMING_AMP 4
#endif
    unsigned long long tsel = 0, tph0 = 0;
#define PHASE_BEGIN(cat) if (ph >= lo && ph < hi) { if (TIMING_MASK & (1 << (cat))) tph0 = __builtin_amdgcn_s_memrealtime();
#define PHASE_END(cat) if (ph + 1 < hi) grid.sync(); if (TIMING_MASK & (1 << (cat))) tsel += __builtin_amdgcn_s_memrealtime() - tph0; } ++ph;
    hf* H = (hf*)(P.ws + WS_H); hf* HID = (hf*)(P.ws + WS_BIG); float* PROJ = (float*)(P.ws + WS_BIG); hf* YC = (hf*)(P.ws + WS_YCAT); hf* OM = (hf*)(P.ws + WS_OMEM);
    int* CNT = (int*)(P.ws + WS_CNT);
    float* X = P.out;

    float* PSS = (float*)(P.ws + WS_PSS);
    LAS float* RS = (LAS float*)(lds + 131072);
    PHASE_BEGIN(0)
        if (bid == 0 && threadIdx.x < 64) CNT[threadIdx.x] = 0;
        convert_static(P, lds, bid, nb);
        for (int l = 0; l < NL; ++l) norm_rows(P.in[1], P.in[21] + l * DM, (hf*)(P.ws + WS_MEMH) + (size_t)l * 1024 * DM, 1024, bid, nb);
        norm_rows(P.in[0], P.in[3], H, MT, bid, nb, PSS);
    PHASE_END(0)

    constexpr int QG = 4;
    for (int l = 0; l < NL; ++l) {
        const hf* W = (const hf*)(P.ws + WS_W) + (size_t)l * E_LAYER;
        const float* xin = (l == 0) ? P.in[0] : X;
        PHASE_BEGIN(1)
            { pg8::Gemm g{H, W + O_GU1, MT, 2 * DFF, DM}; pg8::StaticOrder S; S.init(MT, 2 * DFF, nb, bid); pg8::fill_rs(RS, PSS, S); pg8::EpiSwiGLU E{HID, DFF, RS}; pg8::gemm_phase(lds, g, S, E); }
            conv_pull(P, lds, l == 0 ? 704 : 6272, bid >= 128 ? QG : 0);
        PHASE_END(1)
        PHASE_BEGIN(2)
            { pg8::Gemm g{HID, W + O_DN1, MT, DM, DFF}; pg8::StaticOrder S; S.init(MT, DM, nb, bid); pg8::EpiRes E{xin, X, P.in[7] + l * DM, H, PSS, DM, 0.5f}; pg8::gemm_phase(lds, g, S, E); }
            conv_pull(P, lds, l == 0 ? 1664 : 6976, 0);
        PHASE_END(2)
        PHASE_BEGIN(4)
            { pg8::Gemm g{H, W + O_WIN, MT, PW, DM}; pg8::StaticOrder S; S.init(MT, PW, nb, bid); pg8::fill_rs(RS, PSS, S); pg8::EpiH16 E{(hf*)(P.ws + WS_BIG), PW, RS}; pg8::gemm_phase(lds, g, S, E); }
            if (l == 0) {
                for (int l2 = 0; l2 < NL; ++l2) { pg8::Gemm g{(const hf*)(P.ws + WS_MEMH) + (size_t)l2 * 1024 * DM, (const hf*)(P.ws + WS_W) + (size_t)l2 * E_LAYER + O_WKV, 1024, 1024, DM};
                    pg8::StaticOrder S; S.init(1024, 1024, nb, (bid + nb - 192 - 16 * l2) % nb); pg8::EpiF32 E{(float*)(P.ws + WS_MEMKV) + (size_t)l2 * 1024 * 1024, 1024, nullptr}; pg8::gemm_phase(lds, g, S, E); }
            }
            conv_pull(P, lds, l == 0 ? 1920 : 7232, (bid >= (l == 0 ? 224 : 192)) ? QG : 0);
        PHASE_END(4)
        PHASE_BEGIN(5)
            post_proj(P, l, lds, bid, nb);
            if (l == 0) memkv_post(P, bid, nb);
        PHASE_END(5)
        PHASE_BEGIN(6)
            for (;;) {
                const int it = next_item(lds, CNT + l * 4 + 0);
                if (it >= 768 + 512) break;
                if (it < 768) { const int rnd = it / 48, w = it % 48, qt = 15 - rnd; if (w < 24) diff_item(P, l, lds, w, qt); else moba_item(P, l, lds, w - 24, qt); }
                else conv_item(P, l, lds, it - 768);
            }
        PHASE_END(6)
        PHASE_BEGIN(7)
            { pg8::Gemm g{YC, W + O_WOUT, MT, DM, DM}; pg8::StaticOrder S; S.init(MT, DM, nb, bid); pg8::EpiRes E{X, X, P.in[20] + l * DM, H, PSS, DM, 1.0f}; pg8::gemm_phase(lds, g, S, E); }
            conv_pull(P, lds, l == 0 ? 1984 : 7296, 0);
        PHASE_END(7)
        PHASE_BEGIN(8)
            { pg8::Gemm g{H, W + O_WQ, MT, 512, DM}; pg8::StaticOrder S; S.init(MT, 512, nb, bid); pg8::fill_rs(RS, PSS, S); pg8::EpiF32 E{(float*)(P.ws + WS_BIG), 512, RS}; pg8::gemm_phase(lds, g, S, E); }
            conv_pull(P, lds, l == 0 ? 2048 : 7360, bid >= 64 ? QG : 0);
        PHASE_END(8)
        PHASE_BEGIN(9)
            for (int it = bid; it < 256; it += nb) { __syncthreads(); mem_item(P, l, lds, it); }
        PHASE_END(9)
        PHASE_BEGIN(10)
            { pg8::Gemm g{OM, W + O_WO, MT, DM, 512}; pg8::StaticOrder S; S.init(MT, DM, nb, bid); pg8::EpiRes E{X, X, P.in[27] + l * DM, H, PSS, DM, 1.0f}; pg8::gemm_phase(lds, g, S, E); }
            conv_pull(P, lds, l == 0 ? 3456 : 8768, 0);
        PHASE_END(10)
        PHASE_BEGIN(1)
            { pg8::Gemm g{H, W + O_GU2, MT, 2 * DFF, DM}; pg8::StaticOrder S; S.init(MT, 2 * DFF, nb, bid); pg8::fill_rs(RS, PSS, S); pg8::EpiSwiGLU E{HID, DFF, RS}; pg8::gemm_phase(lds, g, S, E); }
            conv_pull(P, lds, l == 0 ? 4160 : 9472, bid >= 128 ? QG : 0);
        PHASE_END(1)
        PHASE_BEGIN(2)
            { pg8::Gemm g{HID, W + O_DN2, MT, DM, DFF}; pg8::StaticOrder S; S.init(MT, DM, nb, bid); pg8::EpiRes E{X, X, (l + 1 < NL) ? P.in[3] + (l + 1) * DM : nullptr, H, PSS, DM, 0.5f}; pg8::gemm_phase(lds, g, S, E); }
            if (l + 1 < NL) conv_pull(P, lds, 5568, 0);
        PHASE_END(2)
    }
    if (TIMING_MASK != 0 && bid == 0 && threadIdx.x == 0) { const unsigned long long t1 = __builtin_amdgcn_s_memrealtime(); while (__builtin_amdgcn_s_memrealtime() - t1 < (unsigned long long)TIMING_AMP * tsel) __builtin_amdgcn_s_sleep(8); }
}

extern "C" void kernel_launch(void* const* d_in, const int* in_sizes, int n_in, void* d_out, int out_size, void* d_ws, size_t ws_size, hipStream_t stream) {
    static int grid_blocks = 0;
    if (grid_blocks == 0) {
        if (n_in != 31 || out_size != MT * DM || ws_size < WS_END) { fprintf(stderr, "kernel_launch: unexpected shapes (n_in %d out %d ws %zu need %zu)\n", n_in, out_size, ws_size, (size_t)WS_END); grid_blocks = -1; return; }
        int dev = 0, cus = 0, per_cu = 0;
        hipGetDevice(&dev);
        hipDeviceGetAttribute(&cus, hipDeviceAttributeMultiprocessorCount, dev);
        if (hipFuncSetAttribute((const void*)fwd_mega, hipFuncAttributeMaxDynamicSharedMemorySize, LDS_BYTES) != hipSuccess) { fprintf(stderr, "hipFuncSetAttribute failed\n"); grid_blocks = -1; return; }
        hipOccupancyMaxActiveBlocksPerMultiprocessor(&per_cu, (const void*)fwd_mega, 512, LDS_BYTES);
        if (per_cu < 1) { fprintf(stderr, "occupancy query says %d blocks per CU\n", per_cu); per_cu = 1; }
        (void)hipGetLastError();
        grid_blocks = cus;
    }
    if (grid_blocks < 0) return;
    Params p{};
    for (int i = 0; i < 31; ++i) p.in[i] = (const float*)d_in[i];
    p.out = (float*)d_out; p.ws = (unsigned char*)d_ws; p.ph_lo = 0; p.ph_hi = 1000;
    void* args[] = {&p};
    hipError_t e = hipLaunchCooperativeKernel((const void*)fwd_mega, dim3(grid_blocks), dim3(512), args, LDS_BYTES, stream);
    if (e != hipSuccess) fprintf(stderr, "cooperative launch failed: %s (grid %d)\n", hipGetErrorString(e), grid_blocks);
}
```

```cpp
#include <hip/hip_runtime.h>
#include <hip/hip_cooperative_groups.h>
#include <cstdio>
namespace cg = cooperative_groups;

#define LAS __attribute__((address_space(3)))
typedef _Float16 hf;
typedef _Float16 h8 __attribute__((ext_vector_type(8)));
typedef _Float16 h4 __attribute__((ext_vector_type(4)));
typedef float f32x4 __attribute__((ext_vector_type(4)));

constexpr int DM = 2048, NB = 4, SQ = 2048, MT = NB * SQ, DFF = 5632, PW = 5632, NL = 2;
constexpr int CONVC = 512, CONVW = 31, MEML = 256;
constexpr float LOG2E = 1.4426950408889634f;
constexpr float NEGV = -1e30f;
constexpr int LDS_BYTES = 147456;

constexpr size_t E_GU = (size_t)2 * DFF * DM, E_DN = (size_t)DM * DFF, E_WIN = (size_t)PW * DM, E_WOUT = (size_t)DM * DM, E_WQ = (size_t)512 * DM, E_WKV = (size_t)1024 * DM, E_WO = (size_t)DM * 512;
constexpr size_t O_GU1 = 0, O_DN1 = O_GU1 + E_GU, O_WIN = O_DN1 + E_DN, O_WOUT = O_WIN + E_WIN, O_WQ = O_WOUT + E_WOUT, O_WKV = O_WQ + E_WQ, O_WO = O_WKV + E_WKV, O_GU2 = O_WO + E_WO, O_DN2 = O_GU2 + E_GU, E_LAYER = O_DN2 + E_DN;
constexpr size_t WS_W = 0;
constexpr size_t WS_H = WS_W + 2 * E_LAYER * 2;
constexpr size_t WS_BIG = WS_H + (size_t)MT * DM * 2;
constexpr size_t WS_U = WS_BIG + (size_t)MT * PW * 4;
constexpr size_t WS_MQ = WS_U + (size_t)MT * 512 * 4;
constexpr size_t WS_MK = WS_MQ + (size_t)MT * 768 * 2;
constexpr size_t WS_MVT = WS_MK + (size_t)MT * 768 * 2;
constexpr size_t WS_DQ = WS_MVT + (size_t)MT * 768 * 2;
constexpr size_t WS_DK = WS_DQ + (size_t)MT * 768 * 2;
constexpr size_t WS_DVT = WS_DK + (size_t)MT * 768 * 2;
constexpr size_t WS_YCAT = WS_DVT + (size_t)MT * 768 * 2;
constexpr size_t WS_KPART = WS_YCAT + (size_t)MT * DM * 2;
constexpr size_t WS_MEMH = WS_KPART + (size_t)4 * 64 * 768 * 4;
constexpr size_t WS_MEMKV = WS_MEMH + (size_t)2 * 1024 * DM * 2;
constexpr size_t WS_MEMK = WS_MEMKV + (size_t)2 * 1024 * 1024 * 4;
constexpr size_t WS_MEMVT = WS_MEMK + (size_t)2 * 1024 * 512 * 2;
constexpr size_t WS_OMEM = WS_MEMVT + (size_t)2 * 1024 * 512 * 2;
constexpr size_t WS_CNT = WS_OMEM + (size_t)MT * 512 * 2;
constexpr size_t WS_PSS = WS_CNT + 256;
constexpr size_t WS_END = WS_PSS + (size_t)MT * 32 * 4;

struct Params {
    const float* in[31];
    float* out;
    unsigned char* ws;
    int ph_lo, ph_hi;
};

__device__ __forceinline__ int otid() { int t = threadIdx.x; asm volatile("" : "+v"(t)); return t; }
namespace pg8 {
constexpr int BM = 256, BK = 64, HALF = 128, HTB = HALF * BK * 2, STAGE_BYTES = 8 * HTB, NXCD = 8, WGM = 8;
__host__ __device__ __forceinline__ int lds_byte(int r, int c) { const int st = (r >> 4) * 2 + (c >> 5), rr = r & 15, cc = c & 31, ob = rr * 64 + cc * 2; return st * 1024 + (ob ^ (((ob >> 9) & 1) << 5)); }
__host__ __device__ __forceinline__ void stage_rc(int b, int& R, int& C) { const int st = b / 1024, sb = b % 1024, swz = sb ^ (((sb >> 9) & 1) << 5); R = (st >> 1) * 16 + swz / 64; C = (st & 1) * 32 + (swz % 64) / 2; }
__host__ __device__ __forceinline__ int perm32(int rho) { const int n = rho >> 4, i = rho & 15; return 8 * (i >> 2) + 4 * n + (i & 3); }
struct Unit { int pm, pn; };
struct Gemm { const hf* A; const hf* Bt; int M, N, K; };
struct StaticOrder {
    int nM, nN, nwg, G, c;
    __device__ __forceinline__ void init(int M, int N, int G_, int c_) { nM = M / BM; nN = N / BM; nwg = nM * nN; G = G_; c = c_; }
    __device__ __forceinline__ bool next(int i, Unit& u) const {
        const long L = (long)i * G + c; if (L >= nwg) return false;
        int wgid = (int)L; { const int q = nwg / NXCD, r = nwg % NXCD, xcd = wgid % NXCD, off = wgid / NXCD; wgid = (xcd < r ? xcd * (q + 1) : r * (q + 1) + (xcd - r) * q) + off; }
        const int nig = WGM * nN, gid = wgid / nig, fm = gid * WGM, gsz = (nM - fm) < WGM ? (nM - fm) : WGM;
        u.pm = fm + ((wgid % nig) % gsz); u.pn = (wgid % nig) / gsz; return true;
    }
};
struct EpiF32 {
    static constexpr bool PERM = false;
    float* C; int ldc; LAS const float* rs;
    __device__ __forceinline__ void operator()(const f32x4 (&acc)[2][2][4][2], const Unit& u, int ui, int wr, int wc, int fr, int fq) const {
        const int row0 = u.pm * BM + wr * 64 + fr, col0 = u.pn * BM + wc * 32 + 4 * fq;
#pragma unroll
        for (int ai = 0; ai < 2; ++ai)
#pragma unroll
            for (int m = 0; m < 4; ++m) { float* rowp = C + (size_t)(row0 + ai * HALF + m * 16) * ldc + col0; const float sc = rs ? rs[ui * 256 + wr * 64 + fr + ai * HALF + m * 16] : 1.0f;
#pragma unroll
                for (int bj = 0; bj < 2; ++bj)
#pragma unroll
                    for (int n = 0; n < 2; ++n) *(f32x4*)(rowp + bj * HALF + n * 16) = acc[ai][bj][m][n] * sc; }
    }
};
struct EpiRes {
    static constexpr bool PERM = true;
    const float* base; float* out; const float* gn; hf* xg; float* pss; int ldc; float scale;
    __device__ __forceinline__ void operator()(const f32x4 (&acc)[2][2][4][2], const Unit& u, int ui, int wr, int wc, int fr, int fq) const {
        const int row0 = u.pm * BM + wr * 64 + fr, col0 = u.pn * BM + wc * 32 + 8 * fq;
        f32x4 gg[2][2];
#pragma unroll
        for (int bj = 0; bj < 2; ++bj)
#pragma unroll
            for (int n = 0; n < 2; ++n) gg[bj][n] = gn ? *(const f32x4*)(gn + col0 + bj * HALF + n * 4) : (f32x4){0.f, 0.f, 0.f, 0.f};
#pragma unroll
        for (int ai = 0; ai < 2; ++ai)
#pragma unroll
            for (int mp = 0; mp < 2; ++mp) {
                f32x4 b[2][2][2];
#pragma unroll
                for (int mm = 0; mm < 2; ++mm) { const size_t off = (size_t)(row0 + ai * HALF + (mp * 2 + mm) * 16) * ldc + col0;
#pragma unroll
                    for (int bj = 0; bj < 2; ++bj)
#pragma unroll
                        for (int n = 0; n < 2; ++n) b[mm][bj][n] = *(const f32x4*)(base + off + bj * HALF + n * 4); }
                __builtin_amdgcn_sched_barrier(0);
#pragma unroll
                for (int mm = 0; mm < 2; ++mm) { const int m = mp * 2 + mm, row = row0 + ai * HALF + m * 16; const size_t off = (size_t)row * ldc + col0; float ss = 0.f;
#pragma unroll
                    for (int bj = 0; bj < 2; ++bj) { h8 w;
#pragma unroll
                        for (int n = 0; n < 2; ++n) { const f32x4 o = b[mm][bj][n] + acc[ai][bj][m][n] * scale; *(f32x4*)(out + off + bj * HALF + n * 4) = o;
#pragma unroll
                            for (int j = 0; j < 4; ++j) { w[n * 4 + j] = (hf)(o[j] * gg[bj][n][j]); ss += o[j] * o[j]; } }
                        if (gn) *(h8*)(xg + off + bj * HALF) = w; }
                    if (gn) { ss += __shfl_xor(ss, 16); ss += __shfl_xor(ss, 32); if (fq == 0) pss[(size_t)row * 32 + u.pn * 4 + wc] = ss; } }
                __builtin_amdgcn_sched_barrier(0);
            }
    }
};
struct EpiH16 {
    static constexpr bool PERM = true;
    hf* C; int ldc; LAS const float* rs;
    __device__ __forceinline__ void operator()(const f32x4 (&acc)[2][2][4][2], const Unit& u, int ui, int wr, int wc, int fr, int fq) const {
        const int row0 = u.pm * BM + wr * 64 + fr, col0 = u.pn * BM + wc * 32 + 8 * fq;
#pragma unroll
        for (int ai = 0; ai < 2; ++ai)
#pragma unroll
            for (int m = 0; m < 4; ++m) { hf* rowp = C + (size_t)(row0 + ai * HALF + m * 16) * ldc + col0; const float sc = rs[ui * 256 + wr * 64 + fr + ai * HALF + m * 16];
#pragma unroll
                for (int bj = 0; bj < 2; ++bj) { h8 w;
#pragma unroll
                    for (int n = 0; n < 2; ++n)
#pragma unroll
                        for (int j = 0; j < 4; ++j) w[n * 4 + j] = (hf)(acc[ai][bj][m][n][j] * sc);
                    *(h8*)(rowp + bj * HALF) = w; } }
    }
};
struct EpiSwiGLU {
    static constexpr bool PERM = true;
    hf* O; int ldc; LAS const float* rs;
    __device__ __forceinline__ void operator()(const f32x4 (&acc)[2][2][4][2], const Unit& u, int ui, int wr, int wc, int fr, int fq) const {
        const int row0 = u.pm * BM + wr * 64 + fr, col0 = u.pn * HALF + wc * 32 + 8 * fq;
#pragma unroll
        for (int ai = 0; ai < 2; ++ai)
#pragma unroll
            for (int m = 0; m < 4; ++m) { hf* rowp = O + (size_t)(row0 + ai * HALF + m * 16) * ldc + col0; h8 w; const float sc = rs[ui * 256 + wr * 64 + fr + ai * HALF + m * 16];
#pragma unroll
                for (int n = 0; n < 2; ++n)
#pragma unroll
                    for (int j = 0; j < 4; ++j) { const float g = acc[ai][0][m][n][j] * sc, up = acc[ai][1][m][n][j] * sc; const float sg = g * __builtin_amdgcn_rcpf(1.0f + __expf(-g)); w[n * 4 + j] = (hf)(sg * up); }
                *(h8*)rowp = w; }
    }
};
template <class Sched>
__device__ __forceinline__ void fill_rs(LAS float* RS, const float* pss, const Sched& S) {
    const int tid = otid(); const int r = tid >> 1, hh = tid & 1;
    f32x4 v[6][4]; unsigned okm = 0u;
#pragma unroll
    for (int ui = 0; ui < 6; ++ui) { Unit u; u.pm = 0; u.pn = 0; const bool ok = S.next(ui, u); okm |= ok ? (1u << ui) : 0u;
        const float* pp = pss + (size_t)((ok ? u.pm : 0) * BM + r) * 32 + hh * 16;
#pragma unroll
        for (int e = 0; e < 4; ++e) v[ui][e] = *(const f32x4*)(pp + e * 4); }
#pragma unroll
    for (int ui = 0; ui < 6; ++ui) { float a = 0.f;
#pragma unroll
        for (int e = 0; e < 4; ++e) a += (v[ui][e][0] + v[ui][e][1]) + (v[ui][e][2] + v[ui][e][3]);
        a += __shfl_xor(a, 1);
        if (hh == 0 && ((okm >> ui) & 1u)) RS[ui * 256 + r] = rsqrtf(a * (1.0f / DM) + 1e-6f); }
    __syncthreads();
}
template <class Epi, class Sched>
__device__ __forceinline__ void gemm_phase(LAS unsigned char* lds, const Gemm g, const Sched& S, const Epi& E) {
    int tid = threadIdx.x; asm volatile("" : "+v"(tid));
    const int wid = __builtin_amdgcn_readfirstlane(tid >> 6), lane = tid & 63, wr = wid >> 2, wc = wid & 3, fr = lane & 15, fq = lane >> 4;
    const int K = g.K, nt = K / BK;
    unsigned voffA[2], voffB[2];
#pragma unroll
    for (int i = 0; i < 2; ++i) { int R, C; stage_rc(tid * 16 + i * 8192, R, C); const int Rb = Epi::PERM ? ((R & ~31) + perm32(R & 31)) : R;
        voffA[i] = (unsigned)(R * K + C) * 2u; voffB[i] = (unsigned)(Rb * K + C) * 2u; }
    const size_t kstep = (size_t)(BK * 2);
    const size_t hstep = (size_t)HALF * K * 2;
    const size_t tstep = 2 * hstep;
    const unsigned ldsw = (unsigned)wid * 1024u;
    const int aoff = lds_byte(wr * 64 + fr, fq * 8), boff = lds_byte(wc * 32 + fr, fq * 8);
#define PG8_SA(b, h) (((b) * 2 + (h)) * HTB)
#define PG8_SB(b, h) ((4 + (b) * 2 + (h)) * HTB)
#define PG8_STAGE(bufoff, gbase, voff) do { _Pragma("unroll") for (int _i = 0; _i < 2; ++_i) \
        __builtin_amdgcn_global_load_lds((const unsigned*)((const char*)(gbase) + (voff)[_i]), (LAS unsigned*)(lds + (bufoff) + ldsw + _i * 8192), 16, 0, 0); } while (0)
#define PG8_LDA(dst, b, h) do { _Pragma("unroll") for (int m = 0; m < 4; ++m) _Pragma("unroll") for (int k = 0; k < 2; ++k) dst[m][k] = *(const LAS h8*)(lds + PG8_SA(b, h) + aoff + m * 2048 + k * 1024); } while (0)
#define PG8_LDB(dst, b, h) do { _Pragma("unroll") for (int n = 0; n < 2; ++n) _Pragma("unroll") for (int k = 0; k < 2; ++k) dst[n][k] = *(const LAS h8*)(lds + PG8_SB(b, h) + boff + n * 2048 + k * 1024); } while (0)
#define PG8_MMA(ai, bj, At, Bt) do { __builtin_amdgcn_s_setprio(1); _Pragma("unroll") for (int m = 0; m < 4; ++m) _Pragma("unroll") for (int n = 0; n < 2; ++n) _Pragma("unroll") for (int k = 0; k < 2; ++k) \
        acc[ai][bj][m][n] = __builtin_amdgcn_mfma_f32_16x16x32_f16(Bt[n][k], At[m][k], acc[ai][bj][m][n], 0, 0, 0); __builtin_amdgcn_s_setprio(0); } while (0)
#define PG8_WAIT_V(n) asm volatile("s_waitcnt vmcnt(" #n ")" ::: "memory")
#define PG8_WAIT_L(n) asm volatile("s_waitcnt lgkmcnt(" #n ")" ::: "memory")
#define PG8_BAR __builtin_amdgcn_s_barrier()
#define PG8_SCHED __builtin_amdgcn_sched_barrier(0)
    Unit cur, nxt; int ui = 0;
    if (!S.next(0, cur)) return;
    f32x4 acc[2][2][4][2];
#pragma unroll
    for (int a = 0; a < 2; ++a)
#pragma unroll
        for (int b = 0; b < 2; ++b)
#pragma unroll
            for (int m = 0; m < 4; ++m)
#pragma unroll
                for (int n = 0; n < 2; ++n) acc[a][b][m][n] = (f32x4){0.f, 0.f, 0.f, 0.f};
    h8 At[4][2], B0[2][2], B1[2][2];
    const char* cA = (const char*)g.A + (size_t)cur.pm * tstep; const char* cB = (const char*)g.Bt + (size_t)cur.pn * tstep;
    PG8_STAGE(PG8_SB(0, 0), cB, voffB); PG8_STAGE(PG8_SB(0, 1), cB + hstep, voffB); PG8_STAGE(PG8_SA(0, 0), cA, voffA); PG8_STAGE(PG8_SA(0, 1), cA + hstep, voffA);
    if (wr == 1) PG8_BAR;
    PG8_WAIT_V(2); PG8_BAR;
    PG8_STAGE(PG8_SB(1, 0), cB + kstep, voffB); PG8_STAGE(PG8_SA(1, 0), cA + kstep, voffA); PG8_STAGE(PG8_SB(1, 1), cB + hstep + kstep, voffB);
    PG8_WAIT_V(6); PG8_BAR;
    for (;;) {
        const bool has_next = S.next(ui + 1, nxt);
        const char* nA = has_next ? (const char*)g.A + (size_t)nxt.pm * tstep : cA; const char* nB = has_next ? (const char*)g.Bt + (size_t)nxt.pn * tstep : cB;
        for (int t = 0; t < nt; t += 2) {
            const bool last = (t == nt - 2);
            const char* a1 = cA + (size_t)(t + 1) * kstep;
            const char* a2 = last ? nA : cA + (size_t)(t + 2) * kstep; const char* b2 = last ? nB : cB + (size_t)(t + 2) * kstep;
            const char* a3 = a2 + kstep; const char* b3 = b2 + kstep;
            PG8_LDB(B0, 0, 0); PG8_LDB(B1, 0, 1); PG8_SCHED; PG8_LDA(At, 0, 0); PG8_STAGE(PG8_SA(1, 1), a1 + hstep, voffA);
            PG8_WAIT_V(8); PG8_WAIT_L(0); PG8_BAR; PG8_MMA(0, 0, At, B0); PG8_MMA(0, 1, At, B1); PG8_BAR; PG8_SCHED;
            PG8_LDA(At, 0, 1); PG8_STAGE(PG8_SB(0, 0), b2, voffB); PG8_STAGE(PG8_SB(0, 1), b2 + hstep, voffB); PG8_STAGE(PG8_SA(0, 0), a2, voffA);
            PG8_WAIT_V(8); PG8_WAIT_L(0); PG8_BAR; PG8_MMA(1, 0, At, B0); PG8_MMA(1, 1, At, B1); PG8_BAR; PG8_SCHED;
            PG8_LDB(B0, 1, 0); PG8_LDB(B1, 1, 1); PG8_SCHED; PG8_LDA(At, 1, 0); PG8_STAGE(PG8_SA(0, 1), a2 + hstep, voffA);
            PG8_WAIT_V(8); PG8_WAIT_L(0); PG8_BAR; PG8_MMA(0, 0, At, B0); PG8_MMA(0, 1, At, B1); PG8_BAR; PG8_SCHED;
            PG8_LDA(At, 1, 1); PG8_STAGE(PG8_SB(1, 0), b3, voffB); PG8_STAGE(PG8_SB(1, 1), b3 + hstep, voffB); PG8_STAGE(PG8_SA(1, 0), a3, voffA);
            PG8_WAIT_V(8); PG8_WAIT_L(0); PG8_BAR; PG8_MMA(1, 0, At, B0); PG8_MMA(1, 1, At, B1); PG8_BAR; PG8_SCHED;
        }
        if (wr == 0) PG8_BAR;
        E(acc, cur, ui, wr, wc, fr, fq);
        if (!has_next) break;
#pragma unroll
        for (int a = 0; a < 2; ++a)
#pragma unroll
            for (int b = 0; b < 2; ++b)
#pragma unroll
                for (int m = 0; m < 4; ++m)
#pragma unroll
                    for (int n = 0; n < 2; ++n) acc[a][b][m][n] = (f32x4){0.f, 0.f, 0.f, 0.f};
        cur = nxt; cA = nA; cB = nB; ++ui;
        if (wr == 1) PG8_BAR;
    }
    PG8_WAIT_V(0);
    PG8_BAR;
#undef PG8_SA
#undef PG8_SB
#undef PG8_STAGE
#undef PG8_LDA
#undef PG8_LDB
#undef PG8_MMA
#undef PG8_WAIT_V
#undef PG8_WAIT_L
#undef PG8_BAR
#undef PG8_SCHED
}
}

__device__ __forceinline__ float wave_sum(float v) {
#pragma unroll
    for (int o = 32; o >= 1; o >>= 1) v += __shfl_xor(v, o);
    return v;
}
__device__ __forceinline__ float sigmoidf_(float x) { return 1.0f / (1.0f + __expf(-x)); }

struct ConvJob { const float* src; hf* dst; int K, N, mode; };
constexpr int NQJ = 20;
constexpr int QT_TOTAL = 9472;
__device__ __forceinline__ ConvJob get_job(const Params& P, int l, int j) {
    hf* wb = (hf*)(P.ws + WS_W) + (size_t)l * E_LAYER;
    ConvJob r;
    switch (j) {
    case 0: r = {P.in[4] + (size_t)l * DM * DFF, wb + O_GU1, DM, DFF, 1}; break;
    case 1: r = {P.in[5] + (size_t)l * DM * DFF, wb + O_GU1, DM, DFF, 2}; break;
    case 2: r = {P.in[6] + (size_t)l * DFF * DM, wb + O_DN1, DFF, DM, 0}; break;
    case 3: r = {P.in[8] + (size_t)l * DM * PW, wb + O_WIN, DM, PW, 0}; break;
    case 4: r = {P.in[19] + (size_t)l * DM * DM, wb + O_WOUT, DM, DM, 0}; break;
    case 5: r = {P.in[22] + (size_t)l * DM * 512, wb + O_WQ, DM, 512, 0}; break;
    case 6: r = {P.in[23] + (size_t)l * DM * 1024, wb + O_WKV, DM, 1024, 0}; break;
    case 7: r = {P.in[26] + (size_t)l * 512 * DM, wb + O_WO, 512, DM, 0}; break;
    case 8: r = {P.in[28] + (size_t)l * DM * DFF, wb + O_GU2, DM, DFF, 1}; break;
    case 9: r = {P.in[29] + (size_t)l * DM * DFF, wb + O_GU2, DM, DFF, 2}; break;
    default: r = {P.in[30] + (size_t)l * DFF * DM, wb + O_DN2, DFF, DM, 0}; break;
    }
    return r;
}
__device__ __forceinline__ void convert_tile(const ConvJob jb, int r, LAS unsigned char* lds) {
    const int tid = otid();
    LAS unsigned* T = (LAS unsigned*)lds;
    const int ntn = jb.N >> 8, tn = r % ntn, tk = r / ntn, n0 = tn * 256, k0 = tk * 64;
    const int n4 = (tid & 63) * 4, kr = tid >> 6;
    f32x4 v[8];
#pragma unroll
    for (int p = 0; p < 8; ++p) v[p] = *(const f32x4*)(jb.src + (size_t)(k0 + 2 * (kr + 8 * (p >> 1)) + (p & 1)) * jb.N + n0 + n4);
#pragma unroll
    for (int p = 0; p < 4; ++p) { const int k2 = kr + 8 * p; typedef unsigned u32x4 __attribute__((ext_vector_type(4))); u32x4 w;
#pragma unroll
        for (int e = 0; e < 4; ++e) { typedef _Float16 h2 __attribute__((ext_vector_type(2))); h2 t; t[0] = (hf)v[2 * p][e]; t[1] = (hf)v[2 * p + 1][e]; w[e] = __builtin_bit_cast(unsigned, t); }
        *(LAS u32x4*)(T + k2 * 260 + n4) = w; }
    __syncthreads();
    { const int n = tid & 255, hh = tid >> 8; const int gn = n0 + n;
      const int row = jb.mode == 0 ? gn : ((gn >> 7) * 256 + (gn & 127) + (jb.mode == 2 ? 128 : 0));
      hf* dp = jb.dst + (size_t)row * jb.K + k0 + hh * 32;
#pragma unroll
      for (int c = 0; c < 4; ++c) { typedef unsigned u32x4 __attribute__((ext_vector_type(4))); u32x4 w;
#pragma unroll
          for (int e = 0; e < 4; ++e) w[e] = T[(hh * 16 + c * 4 + e) * 260 + n];
          *(u32x4*)(dp + c * 8) = w; } }
    __syncthreads();
}
__device__ __forceinline__ void queue_tile(const Params& P, int slot, LAS unsigned char* lds) {
    constexpr int QL[NQJ] = {0, 0, 1, 0, 0, 0, 0, 0, 0, 0, 1, 1, 1, 1, 1, 1, 1, 1, 1, 1};
    constexpr int QJ[NQJ] = {2, 6, 6, 3, 4, 5, 7, 8, 9, 10, 0, 1, 2, 3, 4, 5, 7, 8, 9, 10};
    constexpr int QN[NQJ] = {704, 128, 128, 704, 256, 64, 64, 704, 704, 704, 704, 704, 704, 704, 256, 64, 64, 704, 704, 704};
    int r = slot, q = 0;
#pragma unroll
    for (int t = 0; t < NQJ - 1; ++t) { if (q == t && r >= QN[t]) { r -= QN[t]; q = t + 1; } }
    int l = 0, j = 0;
#pragma unroll
    for (int t = 0; t < NQJ; ++t) { if (q == t) { l = QL[t]; j = QJ[t]; } }
    convert_tile(get_job(P, l, j), r, lds);
}
__device__ __forceinline__ void conv_pull(const Params& P, LAS unsigned char* lds, int req, int quota) {
    constexpr int CL = 4;
    LAS int* misc = (LAS int*)(lds + 115968);
    int* q = (int*)(P.ws + WS_CNT) + 32;
    for (int n = 0;; n += CL) {
        __syncthreads();
        if (threadIdx.x == 0) { const int cur = __hip_atomic_load(q, __ATOMIC_RELAXED, __HIP_MEMORY_SCOPE_AGENT); int slot = -1;
            if (cur < QT_TOTAL && (cur < req || n < quota)) slot = atomicAdd(q, CL);
            misc[0] = slot; }
        __syncthreads();
        const int slot = misc[0];
        if (slot < 0 || slot >= QT_TOTAL) break;
        for (int k = 0; k < CL; ++k) if (slot + k < QT_TOTAL) queue_tile(P, slot + k, lds);
    }
}
__device__ __forceinline__ void convert_static(const Params& P, LAS unsigned char* lds, int bid, int nb) {
    for (int idx = bid; idx < 1408; idx += nb) { const int j = idx >= 704; convert_tile(get_job(P, 0, j), idx - j * 704, lds); }
}

__device__ __forceinline__ void norm_rows(const float* __restrict__ src, const float* __restrict__ g, hf* __restrict__ dst, int nrows, int bid, int nb, float* pss = nullptr) {
    const int tid = otid(), wid = tid >> 6, lane = tid & 63;
    for (int row = bid * 8 + wid; row < nrows; row += nb * 8) {
        const float* rp = src + (size_t)row * DM; f32x4 v[8]; float ss = 0.f;
#pragma unroll
        for (int e = 0; e < 8; ++e) { v[e] = *(const f32x4*)(rp + e * 256 + lane * 4); ss += v[e][0] * v[e][0] + v[e][1] * v[e][1] + v[e][2] * v[e][2] + v[e][3] * v[e][3]; }
        ss = wave_sum(ss); float r = rsqrtf(ss * (1.0f / DM) + 1e-6f);
        if (pss) { r = 1.0f; if (lane < 32) pss[(size_t)row * 32 + lane] = lane == 0 ? ss : 0.f; }
#pragma unroll
        for (int e = 0; e < 8; ++e) { const f32x4 gg = *(const f32x4*)(g + e * 256 + lane * 4); h4 w;
#pragma unroll
            for (int j = 0; j < 4; ++j) w[j] = (hf)(v[e][j] * r * gg[j]);
            *(h4*)(dst + (size_t)row * DM + e * 256 + lane * 4) = w; }
    }
}

__device__ __forceinline__ void memkv_post(const Params& P, int bid, int nb) {
    const int tid = otid(), wid = tid >> 6, lane = tid & 63;
    const float* KV = (const float*)(P.ws + WS_MEMKV); hf* MK = (hf*)(P.ws + WS_MEMK); hf* MVT = (hf*)(P.ws + WS_MEMVT);
    for (int row = bid * 8 + wid; row < 2048; row += nb * 8) {
        const int l = row >> 10, b = (row >> 8) & 3, m = row & 255; const float* rp = KV + (size_t)row * 1024;
        const float* kn = P.in[25] + l * 128;
#pragma unroll
        for (int c = 0; c < 2; ++c) {
            const f32x4 v = *(const f32x4*)(rp + c * 256 + lane * 4); float ss = v[0] * v[0] + v[1] * v[1] + v[2] * v[2] + v[3] * v[3];
#pragma unroll
            for (int o = 16; o >= 1; o >>= 1) ss += __shfl_xor(ss, o);
            const float r = rsqrtf(ss * (1.0f / 128) + 1e-6f); const int h = c * 2 + (lane >> 5), d = (lane & 31) * 4; const f32x4 gg = *(const f32x4*)(kn + d); h4 w;
#pragma unroll
            for (int j = 0; j < 4; ++j) w[j] = (hf)(v[j] * r * gg[j]);
            *(h4*)(MK + ((size_t)((l * 4 + b) * 4 + h) * 256 + m) * 128 + d) = w;
        }
#pragma unroll
        for (int c = 0; c < 2; ++c) {
            const f32x4 v = *(const f32x4*)(rp + 512 + c * 256 + lane * 4); const int h = c * 2 + (lane >> 5), d = (lane & 31) * 4;
#pragma unroll
            for (int j = 0; j < 4; ++j) MVT[((size_t)((l * 4 + b) * 4 + h) * 128 + d + j) * 256 + m] = (hf)v[j];
        }
    }
}

__device__ __forceinline__ f32x4 ldh4(const hf* p) { const h4 v = *(const h4*)p; return (f32x4){(float)v[0], (float)v[1], (float)v[2], (float)v[3]}; }
__device__ __forceinline__ f32x4 h4f(const h4 v) { return (f32x4){(float)v[0], (float)v[1], (float)v[2], (float)v[3]}; }
__device__ __forceinline__ void post_proj(const Params& P, int l, LAS unsigned char* lds, int bid, int nb) {
    const int tid = otid(), wid = tid >> 6, lane = tid & 63;
    const hf* PROJ = (const hf*)(P.ws + WS_BIG); float* U = (float*)(P.ws + WS_U);
    hf* MQ = (hf*)(P.ws + WS_MQ); hf* MK = (hf*)(P.ws + WS_MK); hf* MVT = (hf*)(P.ws + WS_MVT);
    hf* DQ = (hf*)(P.ws + WS_DQ); hf* DK = (hf*)(P.ws + WS_DK); hf* DVT = (hf*)(P.ws + WS_DVT); float* KPART = (float*)(P.ws + WS_KPART);
    const float* gmq = P.in[13] + l * 128; const float* gmk = P.in[14] + l * 128; const float* gdq = P.in[15] + l * 64; const float* gdk = P.in[16] + l * 64;
    LAS hf* T = (LAS hf*)lds;
    LAS float* KR = (LAS float*)(lds + 122880);
    const float sc_m = 0.08838834764831845f * LOG2E, sc_d = 0.125f * LOG2E;
    for (int item = bid; item < MT / 32; item += nb) {
        const int b = item >> 6, s0 = (item & 63) * 32;
        f32x4 ksum[3];
#pragma unroll
        for (int c = 0; c < 3; ++c) ksum[c] = (f32x4){0.f, 0.f, 0.f, 0.f};
        h4 rawn[22];
        { const hf* rp0 = PROJ + ((size_t)b * SQ + s0 + wid * 4) * PW;
#pragma unroll
          for (int c = 0; c < 22; ++c) rawn[c] = *(const h4*)(rp0 + c * 256 + lane * 4); }
        for (int it = 0; it < 4; ++it) {
            const int tl = wid * 4 + it, s = s0 + tl; const size_t tok = (size_t)b * SQ + s;
            h4 raw[22];
#pragma unroll
            for (int c = 0; c < 22; ++c) raw[c] = rawn[c];
            { const int itn = it < 3 ? it + 1 : 3; const hf* rpn = PROJ + ((size_t)b * SQ + s0 + wid * 4 + itn) * PW;
#pragma unroll
              for (int c = 0; c < 22; ++c) rawn[c] = *(const h4*)(rpn + c * 256 + lane * 4); }
            __builtin_amdgcn_sched_barrier(0);
#pragma unroll
            for (int c = 0; c < 2; ++c) { const f32x4 a = h4f(raw[c]), gg = h4f(raw[2 + c]); f32x4 u;
#pragma unroll
                for (int j = 0; j < 4; ++j) u[j] = a[j] * sigmoidf_(gg[j]);
                *(f32x4*)(U + tok * 512 + c * 256 + lane * 4) = u; }
#pragma unroll
            for (int c = 0; c < 3; ++c) {
                const int h = c * 2 + (lane >> 5), d = (lane & 31) * 4;
                { const f32x4 v = h4f(raw[4 + c]); float ss = v[0] * v[0] + v[1] * v[1] + v[2] * v[2] + v[3] * v[3];
#pragma unroll
                  for (int o = 16; o >= 1; o >>= 1) ss += __shfl_xor(ss, o);
                  const float r = rsqrtf(ss * (1.0f / 128) + 1e-6f) * sc_m; const f32x4 gg = *(const f32x4*)(gmq + d); h4 w;
#pragma unroll
                  for (int j = 0; j < 4; ++j) w[j] = (hf)(v[j] * r * gg[j]);
                  *(h4*)(MQ + ((size_t)(b * 6 + h) * SQ + s) * 128 + d) = w; }
                { const f32x4 v = h4f(raw[7 + c]); float ss = v[0] * v[0] + v[1] * v[1] + v[2] * v[2] + v[3] * v[3];
#pragma unroll
                  for (int o = 16; o >= 1; o >>= 1) ss += __shfl_xor(ss, o);
                  const float r = rsqrtf(ss * (1.0f / 128) + 1e-6f); const f32x4 gg = *(const f32x4*)(gmk + d); h4 w;
#pragma unroll
                  for (int j = 0; j < 4; ++j) { const float kn = v[j] * r * gg[j]; w[j] = (hf)kn; ksum[c][j] += kn; }
                  *(h4*)(MK + ((size_t)(b * 6 + h) * SQ + s) * 128 + d) = w; }
                { const f32x4 v = h4f(raw[10 + c]);
#pragma unroll
                  for (int j = 0; j < 4; ++j) T[(c * 256 + lane * 4 + j) * 40 + tl] = (hf)v[j]; }
            }
#pragma unroll
            for (int c = 0; c < 3; ++c) {
                const int hc = c * 4 + (lane >> 4), d = (lane & 15) * 4;
                { const f32x4 v = h4f(raw[13 + c]); float ss = v[0] * v[0] + v[1] * v[1] + v[2] * v[2] + v[3] * v[3];
#pragma unroll
                  for (int o = 8; o >= 1; o >>= 1) ss += __shfl_xor(ss, o);
                  const float r = rsqrtf(ss * (1.0f / 64) + 1e-6f) * sc_d; const f32x4 gg = *(const f32x4*)(gdq + d); h4 w;
#pragma unroll
                  for (int j = 0; j < 4; ++j) w[j] = (hf)(v[j] * r * gg[j]);
                  *(h4*)(DQ + ((size_t)(b * 12 + hc) * SQ + s) * 64 + d) = w; }
                { const f32x4 v = h4f(raw[16 + c]); float ss = v[0] * v[0] + v[1] * v[1] + v[2] * v[2] + v[3] * v[3];
#pragma unroll
                  for (int o = 8; o >= 1; o >>= 1) ss += __shfl_xor(ss, o);
                  const float r = rsqrtf(ss * (1.0f / 64) + 1e-6f); const f32x4 gg = *(const f32x4*)(gdk + d); h4 w;
#pragma unroll
                  for (int j = 0; j < 4; ++j) w[j] = (hf)(v[j] * r * gg[j]);
                  *(h4*)(DK + ((size_t)(b * 12 + hc) * SQ + s) * 64 + d) = w; }
                { const f32x4 v = h4f(raw[19 + c]);
#pragma unroll
                  for (int j = 0; j < 4; ++j) T[(768 + c * 256 + lane * 4 + j) * 40 + tl] = (hf)v[j]; }
            }
        }
#pragma unroll
        for (int c = 0; c < 3; ++c) *(LAS f32x4*)(KR + wid * 768 + c * 256 + lane * 4) = ksum[c];
        __syncthreads();
        for (int e = tid; e < 768; e += 512) { float a = 0.f;
#pragma unroll
            for (int w = 0; w < 8; ++w) a += KR[w * 768 + e];
            KPART[(size_t)item * 768 + e] = a; }
        for (int rr = tid; rr < 1536; rr += 512) {
            const int v2 = rr >= 768, r7 = rr - v2 * 768, h = r7 >> 7, d = r7 & 127; hf* dstp = (v2 ? DVT : MVT) + ((size_t)(b * 6 + h) * 128 + d) * SQ + s0;
#pragma unroll
            for (int q = 0; q < 4; ++q) *(h8*)(dstp + q * 8) = *(const LAS h8*)(T + rr * 40 + q * 8);
        }
        __syncthreads();
    }
}

__device__ __forceinline__ void conv_item(const Params& P, int l, LAS unsigned char* lds, int item) {
    const int tid = otid(), wid = tid >> 6, lane = tid & 63;
    const float* U = (const float*)(P.ws + WS_U); hf* Y = (hf*)(P.ws + WS_YCAT);
    const float* cw = P.in[9] + (size_t)l * CONVW * CONVC; const float* cb = P.in[10] + l * CONVC; const float* lg = P.in[11] + l * CONVC; const float* lb = P.in[12] + l * CONVC;
    const int b = item >> 7, s0 = (item & 127) * 16; const int ch = wid * 64 + lane;
    LAS float* UL = (LAS float*)lds;
    LAS float* ST = (LAS float*)(lds + 46 * 2048);
    float w[CONVW];
#pragma unroll
    for (int j = 0; j < CONVW; ++j) w[j] = cw[j * CONVC + ch];
    { f32x4 v[12];
#pragma unroll
      for (int k = 0; k < 12; ++k) { const int e = tid + 512 * k, r = e >> 7, c4 = (e & 127) * 4, s = s0 - 30 + r; const int sc = s < 0 ? 0 : s;
          v[k] = (e < 46 * 128) ? *(const f32x4*)(U + ((size_t)b * SQ + sc) * 512 + c4) : (f32x4){0.f, 0.f, 0.f, 0.f}; if (s < 0) v[k] = (f32x4){0.f, 0.f, 0.f, 0.f}; }
      __builtin_amdgcn_sched_barrier(0);
#pragma unroll
      for (int k = 0; k < 12; ++k) { const int e = tid + 512 * k, r = e >> 7, c4 = (e & 127) * 4; if (e < 46 * 128) *(LAS f32x4*)(UL + r * 512 + c4) = v[k]; } }
    __syncthreads();
    float u[46];
#pragma unroll
    for (int r = 0; r < 46; ++r) u[r] = UL[r * 512 + ch];
    const float bias = cb[ch]; float acc[16];
#pragma unroll
    for (int t = 0; t < 16; ++t) { float a = bias;
#pragma unroll
        for (int j = 0; j < CONVW; ++j) a += w[j] * u[t + j];
        acc[t] = a; }
#pragma unroll
    for (int t = 0; t < 16; ++t) { const float s1 = wave_sum(acc[t]), s2 = wave_sum(acc[t] * acc[t]); if (lane == 0) { ST[(wid * 16 + t) * 2] = s1; ST[(wid * 16 + t) * 2 + 1] = s2; } }
    __syncthreads();
    const float g = lg[ch], be = lb[ch];
#pragma unroll
    for (int t = 0; t < 16; ++t) { float s1 = 0.f, s2 = 0.f;
#pragma unroll
        for (int w8 = 0; w8 < 8; ++w8) { s1 += ST[(w8 * 16 + t) * 2]; s2 += ST[(w8 * 16 + t) * 2 + 1]; }
        const float mu = s1 * (1.0f / 512), var = fmaxf(s2 * (1.0f / 512) - mu * mu, 0.f), rstd = rsqrtf(var + 1e-5f);
        const float y = (acc[t] - mu) * rstd * g + be;
        Y[((size_t)b * SQ + s0 + t) * DM + ch] = (hf)(y * sigmoidf_(y)); }
}

constexpr int A_STG = 0, A_STG_BYTES = 35840, A_QS = 71680, A_LUT = 106496, A_TK0 = 107520, A_SELM = 107776, A_KM = 108288, A_GATE = 111872, A_MISC = 115968;
constexpr int VSTR = 144;
template <int DQK, bool CAUSAL, bool BIAS, bool SEL>
__device__ __forceinline__ void flash_tile(LAS const unsigned char* kb, LAS const float* lut, const h8 (&qf)[DQK / 32], int k0, int q0w, int qpos, int i, int g, unsigned selmask, f32x4 (&O)[8], float& mrow, float& lsum) {
    constexpr int KT_BYTES = DQK * 128, NKK = DQK / 32;
    const bool selok = SEL ? ((selmask >> (k0 >> 8)) & 1u) : true;
    const bool active = (!CAUSAL || k0 <= q0w + 15) && (!SEL || __ballot(selok) != 0ull);
    if (!active) return;
    LAS const unsigned char* vb = kb + KT_BYTES;
    f32x4 sa[4];
    { h8 kf[4][NKK];
#pragma unroll
      for (int st = 0; st < 4; ++st)
#pragma unroll
          for (int kk = 0; kk < NKK; ++kk) kf[st][kk] = *(const LAS h8*)(kb + (kk * 4 + g) * 1024 + (16 * st + i) * 16);
      __builtin_amdgcn_sched_barrier(0);
#pragma unroll
      for (int st = 0; st < 4; ++st) sa[st] = (f32x4){0.f, 0.f, 0.f, 0.f};
#pragma unroll
      for (int kk = 0; kk < NKK; ++kk)
#pragma unroll
          for (int st = 0; st < 4; ++st) sa[st] = __builtin_amdgcn_mfma_f32_16x16x32_f16(kf[st][kk], qf[kk], sa[st], 0, 0, 0); }
    h8 vf[8][2];
#pragma unroll
    for (int dt = 0; dt < 8; ++dt)
#pragma unroll
        for (int s2 = 0; s2 < 2; ++s2) vf[dt][s2] = *(const LAS h8*)(vb + (4 * s2 + g) * 2048 + (16 * dt + i) * 16);
    __builtin_amdgcn_sched_barrier(0);
    if (BIAS) {
        const bool far = (k0 + 63 + 128 <= q0w);
        if (far) { const float bc = lut[128];
#pragma unroll
            for (int st = 0; st < 4; ++st)
#pragma unroll
                for (int r = 0; r < 4; ++r) sa[st][r] += bc;
        } else {
            const int dbase = qpos - k0 - 8 * g; float bv[4][4];
#pragma unroll
            for (int st = 0; st < 4; ++st)
#pragma unroll
                for (int r = 0; r < 4; ++r) { const int dist = dbase - (32 * (st >> 1) + 4 * (st & 1) + r); const int dc = dist < 0 ? 0 : (dist > 128 ? 128 : dist); bv[st][r] = lut[dc]; }
#pragma unroll
            for (int st = 0; st < 4; ++st)
#pragma unroll
                for (int r = 0; r < 4; ++r) asm volatile("" : "+v"(bv[st][r]));
#pragma unroll
            for (int st = 0; st < 4; ++st)
#pragma unroll
                for (int r = 0; r < 4; ++r) { const int dist = dbase - (32 * (st >> 1) + 4 * (st & 1) + r); sa[st][r] = dist >= 0 ? sa[st][r] + bv[st][r] : NEGV; }
        }
    }
    if (SEL) { if (!selok) {
#pragma unroll
        for (int st = 0; st < 4; ++st)
#pragma unroll
            for (int r = 0; r < 4; ++r) sa[st][r] = NEGV; } }
    float mx = NEGV;
#pragma unroll
    for (int st = 0; st < 4; ++st)
#pragma unroll
        for (int r = 0; r < 4; ++r) mx = fmaxf(mx, sa[st][r]);
    mx = fmaxf(mx, __shfl_xor(mx, 16)); mx = fmaxf(mx, __shfl_xor(mx, 32));
    const float mnew = fmaxf(mrow, mx);
    const bool grow = mnew > mrow;
    float ps = 0.f; h8 pf[2];
#pragma unroll
    for (int st = 0; st < 4; ++st)
#pragma unroll
        for (int r = 0; r < 4; ++r) { const float p = __builtin_amdgcn_exp2f(sa[st][r] - mnew); ps += p; pf[st >> 1][(st & 1) * 4 + r] = (hf)p; }
    if (__ballot(grow) != 0ull) {
        const float alpha = __builtin_amdgcn_exp2f(mrow - mnew); lsum *= alpha;
#pragma unroll
        for (int dt = 0; dt < 8; ++dt) O[dt] *= alpha;
    }
    mrow = mnew; lsum += ps;
    __builtin_amdgcn_sched_barrier(0);
#pragma unroll
    for (int s2 = 0; s2 < 2; ++s2)
#pragma unroll
        for (int dt = 0; dt < 8; ++dt) O[dt] = __builtin_amdgcn_mfma_f32_16x16x32_f16(vf[dt][s2], pf[s2], O[dt], 0, 0, 0);
}
template <int DQK, bool CAUSAL, bool BIAS, bool QLDS, bool SEL>
__device__ __forceinline__ void flash_core(LAS unsigned char* lds, const hf* Qb, const hf* Kb, const hf* VTb, int vts, int q0, int ntiles, unsigned selmask, f32x4 (&O)[8], float& lsum) {
    constexpr int KT_BYTES = DQK * 128, NKK = DQK / 32, KCH = DQK / 64, C8M = DQK / 8 - 1, RSH = (DQK == 128) ? 7 : 6;
    int tid = threadIdx.x; asm volatile("" : "+v"(tid));
    const int wid = __builtin_amdgcn_readfirstlane(tid >> 6), lane = tid & 63, i = lane & 15, g = lane >> 4;
    const int q0w = q0 + wid * 16, qpos = q0w + i;
    LAS const int* tk0 = (LAS const int*)(lds + A_TK0); LAS const float* lut = (LAS const float*)(lds + A_LUT);
    h8 qf[NKK];
#pragma unroll
    for (int kk = 0; kk < NKK; ++kk) {
        if (QLDS) qf[kk] = *(const LAS h8*)(lds + A_QS + (wid * 16 + i) * 272 + kk * 64 + g * 16);
        else qf[kk] = *(const h8*)(Qb + (size_t)qpos * DQK + kk * 32 + g * 8);
    }
#pragma unroll
    for (int dt = 0; dt < 8; ++dt) O[dt] = (f32x4){0.f, 0.f, 0.f, 0.f};
    float mrow = NEGV; lsum = 0.f;
    h8 kA[KCH], vA[2], kB[KCH], vB[2];
#define FA_LOADG(kreg, vreg, k0_) do { _Pragma("unroll") for (int e = 0; e < KCH; ++e) { const int c = tid + 512 * e, row = ((c >> RSH) << 3) | (c & 7), c8 = (c >> 3) & C8M; kreg[e] = *(const h8*)(Kb + (size_t)((k0_) + row) * DQK + c8 * 8); } \
        _Pragma("unroll") for (int e = 0; e < 2; ++e) { const int c = tid + 512 * e, d = ((c >> 6) << 3) | (c & 7), k8 = (c >> 3) & 7; vreg[e] = *(const h8*)(VTb + (size_t)d * vts + (k0_) + k8 * 8); } } while (0)
#define FA_STORE(kreg, vreg, buf_) do { LAS unsigned char* sb = lds + A_STG + (buf_) * A_STG_BYTES; \
        _Pragma("unroll") for (int e = 0; e < KCH; ++e) { const int c = tid + 512 * e, row = ((c >> RSH) << 3) | (c & 7), c8 = (c >> 3) & C8M; const int p = (row & 32) | ((row & 4) << 2) | ((row & 24) >> 1) | (row & 3); *(LAS h8*)(sb + c8 * 1024 + p * 16) = kreg[e]; } \
        _Pragma("unroll") for (int e = 0; e < 2; ++e) { const int c = tid + 512 * e, d = ((c >> 6) << 3) | (c & 7), k8 = (c >> 3) & 7; *(LAS h8*)(sb + KT_BYTES + k8 * 2048 + d * 16) = vreg[e]; } } while (0)
    const int ntm1 = ntiles - 1;
#define FA_K0(t_) tk0[(t_) < ntm1 ? (t_) : ntm1]
    { const int k00 = FA_K0(0); FA_LOADG(kA, vA, k00); }
    { const int k01 = FA_K0(1); FA_LOADG(kB, vB, k01); }
    FA_STORE(kA, vA, 0);
    __syncthreads();
    for (int t = 0; t < ntiles; t += 2) {
        { const int kn = FA_K0(t + 2); FA_LOADG(kA, vA, kn); }
        flash_tile<DQK, CAUSAL, BIAS, SEL>(lds + A_STG, lut, qf, tk0[t], q0w, qpos, i, g, selmask, O, mrow, lsum);
        FA_STORE(kB, vB, 1);
        __syncthreads();
        { const int kn = FA_K0(t + 3); FA_LOADG(kB, vB, kn); }
        if (t + 1 < ntiles) flash_tile<DQK, CAUSAL, BIAS, SEL>(lds + A_STG + A_STG_BYTES, lut, qf, tk0[t + 1], q0w, qpos, i, g, selmask, O, mrow, lsum);
        FA_STORE(kA, vA, 0);
        __syncthreads();
    }
#undef FA_K0
#undef FA_LOADG
#undef FA_STORE
}
__device__ __forceinline__ float row_total(float l) { l += __shfl_xor(l, 16); l += __shfl_xor(l, 32); return l; }

__device__ __forceinline__ int t5_bucket(int dist) {
    if (dist < 16) return dist;
    const float lr = logf((float)dist / 16.0f) / 2.0794415416798357f;
    const int v = 16 + (int)(lr * 16.0f);
    return v < 31 ? v : 31;
}
__device__ __forceinline__ void fill_lut(LAS unsigned char* lds, const float* rel_bias, int hcol) {
    LAS float* lut = (LAS float*)(lds + A_LUT);
    for (int d = otid(); d <= 128; d += 512) lut[d] = rel_bias[t5_bucket(d) * 12 + hcol] * LOG2E;
}

constexpr int D_STG_BYTES = 32768, D_K2 = 8192, D_VT = 16384;
__device__ __forceinline__ void flash_tile_dual(LAS const unsigned char* sb, LAS const float* lut, const h8 (&qa)[2], const h8 (&qb)[2], int k0, int q0w, int qpos, int i, int g,
                                                f32x4 (&O1)[8], f32x4 (&O2)[8], float& m1, float& m2, float& l1, float& l2) {
    constexpr int KSTR = 144;
    if (k0 > q0w + 15) return;
    LAS const unsigned char* vb = sb + D_VT;
    f32x4 sa[4], sc[4];
    { h8 k1[4][2], k2[4][2];
#pragma unroll
      for (int st = 0; st < 4; ++st)
#pragma unroll
          for (int kk = 0; kk < 2; ++kk) { k1[st][kk] = *(const LAS h8*)(sb + (kk * 4 + g) * 1024 + (16 * st + i) * 16); k2[st][kk] = *(const LAS h8*)(sb + D_K2 + (kk * 4 + g) * 1024 + (16 * st + i) * 16); }
      __builtin_amdgcn_sched_barrier(0);
#pragma unroll
      for (int st = 0; st < 4; ++st) { sa[st] = (f32x4){0.f, 0.f, 0.f, 0.f}; sc[st] = (f32x4){0.f, 0.f, 0.f, 0.f}; }
#pragma unroll
      for (int kk = 0; kk < 2; ++kk)
#pragma unroll
          for (int st = 0; st < 4; ++st) { sa[st] = __builtin_amdgcn_mfma_f32_16x16x32_f16(k1[st][kk], qa[kk], sa[st], 0, 0, 0); sc[st] = __builtin_amdgcn_mfma_f32_16x16x32_f16(k2[st][kk], qb[kk], sc[st], 0, 0, 0); } }
    __builtin_amdgcn_sched_barrier(0);
    const bool far = (k0 + 63 + 128 <= q0w);
    if (far) { const float bc = lut[128];
#pragma unroll
        for (int st = 0; st < 4; ++st)
#pragma unroll
            for (int r = 0; r < 4; ++r) { sa[st][r] += bc; sc[st][r] += bc; }
    } else {
        const int dbase = qpos - k0 - 8 * g; float bv[4][4];
#pragma unroll
        for (int st = 0; st < 4; ++st)
#pragma unroll
            for (int r = 0; r < 4; ++r) { const int dist = dbase - (32 * (st >> 1) + 4 * (st & 1) + r); const int dc = dist < 0 ? 0 : (dist > 128 ? 128 : dist); bv[st][r] = lut[dc]; }
#pragma unroll
        for (int st = 0; st < 4; ++st)
#pragma unroll
            for (int r = 0; r < 4; ++r) asm volatile("" : "+v"(bv[st][r]));
#pragma unroll
        for (int st = 0; st < 4; ++st)
#pragma unroll
            for (int r = 0; r < 4; ++r) { const int dist = dbase - (32 * (st >> 1) + 4 * (st & 1) + r); sa[st][r] = dist >= 0 ? sa[st][r] + bv[st][r] : NEGV; sc[st][r] = dist >= 0 ? sc[st][r] + bv[st][r] : NEGV; }
    }
    float mx1 = NEGV, mx2 = NEGV;
#pragma unroll
    for (int st = 0; st < 4; ++st)
#pragma unroll
        for (int r = 0; r < 4; ++r) { mx1 = fmaxf(mx1, sa[st][r]); mx2 = fmaxf(mx2, sc[st][r]); }
    mx1 = fmaxf(mx1, __shfl_xor(mx1, 16)); mx1 = fmaxf(mx1, __shfl_xor(mx1, 32));
    mx2 = fmaxf(mx2, __shfl_xor(mx2, 16)); mx2 = fmaxf(mx2, __shfl_xor(mx2, 32));
    const float n1 = fmaxf(m1, mx1), n2 = fmaxf(m2, mx2);
    const bool grow = (n1 > m1) || (n2 > m2);
    float p1s = 0.f, p2s = 0.f; h8 pa[2], pb[2];
#pragma unroll
    for (int st = 0; st < 4; ++st)
#pragma unroll
        for (int r = 0; r < 4; ++r) { const float p1 = __builtin_amdgcn_exp2f(sa[st][r] - n1), p2 = __builtin_amdgcn_exp2f(sc[st][r] - n2); p1s += p1; p2s += p2;
            pa[st >> 1][(st & 1) * 4 + r] = (hf)p1; pb[st >> 1][(st & 1) * 4 + r] = (hf)p2; }
    if (__ballot(grow) != 0ull) {
        const float a1 = __builtin_amdgcn_exp2f(m1 - n1), a2 = __builtin_amdgcn_exp2f(m2 - n2); l1 *= a1; l2 *= a2;
#pragma unroll
        for (int dt = 0; dt < 8; ++dt) { O1[dt] *= a1; O2[dt] *= a2; }
    }
    m1 = n1; m2 = n2; l1 += p1s; l2 += p2s;
    __builtin_amdgcn_sched_barrier(0);
#pragma unroll
    for (int s2 = 0; s2 < 2; ++s2) { h8 vf[8];
#pragma unroll
        for (int dt = 0; dt < 8; ++dt) vf[dt] = *(const LAS h8*)(vb + (4 * s2 + g) * 2048 + (16 * dt + i) * 16);
        __builtin_amdgcn_sched_barrier(0);
#pragma unroll
        for (int dt = 0; dt < 8; ++dt) { O1[dt] = __builtin_amdgcn_mfma_f32_16x16x32_f16(vf[dt], pa[s2], O1[dt], 0, 0, 0); O2[dt] = __builtin_amdgcn_mfma_f32_16x16x32_f16(vf[dt], pb[s2], O2[dt], 0, 0, 0); }
        __builtin_amdgcn_sched_barrier(0); }
}
__device__ __forceinline__ void flash_core_dual(LAS unsigned char* lds, const hf* Q1, const hf* K1, const hf* Q2, const hf* K2, const hf* VTb, int q0, int ntiles,
                                                f32x4 (&O1)[8], f32x4 (&O2)[8], float& l1, float& l2) {
    constexpr int KSTR = 144;
    int tid = threadIdx.x; asm volatile("" : "+v"(tid));
    const int wid = __builtin_amdgcn_readfirstlane(tid >> 6), lane = tid & 63, i = lane & 15, g = lane >> 4;
    const int q0w = q0 + wid * 16, qpos = q0w + i;
    LAS const float* lut = (LAS const float*)(lds + A_LUT);
    h8 qa[2], qb[2];
#pragma unroll
    for (int kk = 0; kk < 2; ++kk) { qa[kk] = *(const h8*)(Q1 + (size_t)qpos * 64 + kk * 32 + g * 8); qb[kk] = *(const h8*)(Q2 + (size_t)qpos * 64 + kk * 32 + g * 8); }
#pragma unroll
    for (int dt = 0; dt < 8; ++dt) { O1[dt] = (f32x4){0.f, 0.f, 0.f, 0.f}; O2[dt] = (f32x4){0.f, 0.f, 0.f, 0.f}; }
    float m1 = NEGV, m2 = NEGV; l1 = 0.f; l2 = 0.f;
    h8 rA[4], rB[4];
    const int krow = ((tid >> 6) << 3) | (tid & 7), kc8 = (tid >> 3) & 7;
    const int kp = (krow & 32) | ((krow & 4) << 2) | ((krow & 24) >> 1) | (krow & 3);
#define FD_LOADG(r, k0_) do { r[0] = *(const h8*)(K1 + (size_t)((k0_) + krow) * 64 + kc8 * 8); r[1] = *(const h8*)(K2 + (size_t)((k0_) + krow) * 64 + kc8 * 8); \
        _Pragma("unroll") for (int e = 0; e < 2; ++e) { const int c = tid + 512 * e, d = ((c >> 6) << 3) | (c & 7), k8 = (c >> 3) & 7; r[2 + e] = *(const h8*)(VTb + (size_t)d * SQ + (k0_) + k8 * 8); } } while (0)
#define FD_STORE(r, buf_) do { LAS unsigned char* sb = lds + A_STG + (buf_) * D_STG_BYTES; *(LAS h8*)(sb + kc8 * 1024 + kp * 16) = r[0]; *(LAS h8*)(sb + D_K2 + kc8 * 1024 + kp * 16) = r[1]; \
        _Pragma("unroll") for (int e = 0; e < 2; ++e) { const int c = tid + 512 * e, d = ((c >> 6) << 3) | (c & 7), k8 = (c >> 3) & 7; *(LAS h8*)(sb + D_VT + k8 * 2048 + d * 16) = r[2 + e]; } } while (0)
    const int ntm1 = ntiles - 1;
#define FD_K0(t_) (64 * ((t_) < ntm1 ? (t_) : ntm1))
    FD_LOADG(rA, FD_K0(0)); FD_LOADG(rB, FD_K0(1));
    FD_STORE(rA, 0);
    __syncthreads();
    for (int t = 0; t < ntiles; t += 2) {
        FD_LOADG(rA, FD_K0(t + 2));
        flash_tile_dual(lds + A_STG, lut, qa, qb, 64 * t, q0w, qpos, i, g, O1, O2, m1, m2, l1, l2);
        FD_STORE(rB, 1);
        __syncthreads();
        FD_LOADG(rB, FD_K0(t + 3));
        if (t + 1 < ntiles) flash_tile_dual(lds + A_STG + D_STG_BYTES, lut, qa, qb, 64 * (t + 1), q0w, qpos, i, g, O1, O2, m1, m2, l1, l2);
        FD_STORE(rA, 0);
        __syncthreads();
    }
#undef FD_LOADG
#undef FD_STORE
#undef FD_K0
}

__device__ __forceinline__ void diff_item(const Params& P, int l, LAS unsigned char* lds, int bh, int qt) {
    const int tid = otid(), wid = __builtin_amdgcn_readfirstlane(tid >> 6), lane = tid & 63, i = lane & 15, g = lane >> 4;
    const int b = bh / 6, h = bh % 6, q0 = qt * 128;
    const hf* DQ = (const hf*)(P.ws + WS_DQ); const hf* DK = (const hf*)(P.ws + WS_DK); const hf* DVT = (const hf*)(P.ws + WS_DVT); hf* Y = (hf*)(P.ws + WS_YCAT);
    fill_lut(lds, P.in[2], 6 + h);
    const int ntiles = (q0 + 128) / 64;
    LAS int* tk0 = (LAS int*)(lds + A_TK0);
    if (tid < ntiles) tk0[tid] = tid * 64;
    const float* lp = P.in[17] + l * 256;
    const float s1 = wave_sum(lp[lane] * lp[64 + lane]), s2 = wave_sum(lp[128 + lane] * lp[192 + lane]);
    const float lam_init = 0.8f - 0.6f * expf(-0.3f * (float)l);
    const float lam = expf(s1) - expf(s2) + lam_init;
    __syncthreads();
    const hf* VT = DVT + (size_t)(b * 6 + h) * 128 * SQ;
    f32x4 O1[8], O2[8]; float l1, l2;
    flash_core_dual(lds, DQ + (size_t)((b * 6 + h) * 2 + 0) * SQ * 64, DK + (size_t)((b * 6 + h) * 2 + 0) * SQ * 64, DQ + (size_t)((b * 6 + h) * 2 + 1) * SQ * 64, DK + (size_t)((b * 6 + h) * 2 + 1) * SQ * 64, VT, q0, ntiles, O1, O2, l1, l2);
    { const float inv = 1.0f / row_total(l1);
#pragma unroll
      for (int dt = 0; dt < 8; ++dt) O1[dt] *= inv; }
    const float inv2 = lam / row_total(l2); float ss = 0.f;
#pragma unroll
    for (int dt = 0; dt < 8; ++dt) { O1[dt] -= O2[dt] * inv2; ss += O1[dt][0] * O1[dt][0] + O1[dt][1] * O1[dt][1] + O1[dt][2] * O1[dt][2] + O1[dt][3] * O1[dt][3]; }
    ss = row_total(ss);
    const float r = rsqrtf(ss * (1.0f / 128) + 1e-6f) * (1.0f - lam_init);
    const float* sg = P.in[18] + l * 128;
    hf* yp = Y + ((size_t)b * SQ + q0 + wid * 16 + i) * DM + 1280 + h * 128;
    f32x4 gg8[8];
#pragma unroll
    for (int dt = 0; dt < 8; ++dt) gg8[dt] = *(const f32x4*)(sg + dt * 16 + g * 4);
#pragma unroll
    for (int dt = 0; dt < 8; ++dt) { h4 w;
#pragma unroll
        for (int j = 0; j < 4; ++j) w[j] = (hf)(O1[dt][j] * r * gg8[dt][j]);
        *(h4*)(yp + dt * 16 + g * 4) = w; }
}

__device__ __forceinline__ void moba_item(const Params& P, int l, LAS unsigned char* lds, int bh, int qt) {
    const int tid = otid(), wid = __builtin_amdgcn_readfirstlane(tid >> 6), lane = tid & 63, i = lane & 15, g = lane >> 4;
    const int b = bh / 6, h = bh % 6, q0 = qt * 128, cur = q0 >> 8;
    const hf* MQ = (const hf*)(P.ws + WS_MQ) + (size_t)(b * 6 + h) * SQ * 128; const hf* MK = (const hf*)(P.ws + WS_MK) + (size_t)(b * 6 + h) * SQ * 128;
    const hf* MVT = (const hf*)(P.ws + WS_MVT) + (size_t)(b * 6 + h) * 128 * SQ; const float* KPART = (const float*)(P.ws + WS_KPART); hf* Y = (hf*)(P.ws + WS_YCAT);
    fill_lut(lds, P.in[2], h);
    LAS int* tk0 = (LAS int*)(lds + A_TK0); LAS unsigned* selm = (LAS unsigned*)(lds + A_SELM); LAS float* KM = (LAS float*)(lds + A_KM); LAS float* GT = (LAS float*)(lds + A_GATE);
    LAS unsigned* misc = (LAS unsigned*)(lds + A_MISC);
    for (int e = tid; e < cur * 128; e += 512) { const int j = e >> 7, d = e & 127; float a = 0.f;
#pragma unroll
        for (int c = 0; c < 8; ++c) a += KPART[((size_t)b * 64 + j * 8 + c) * 768 + h * 128 + d];
        KM[e] = a * (1.0f / 256); }
    if (tid == 0) misc[1] = 0u;
    __syncthreads();
    {
        const int r = tid >> 2, jj = tid & 3; const hf* qp = MQ + (size_t)(q0 + r) * 128; float g0 = 0.f, g1 = 0.f;
        if (jj < cur) {
            for (int hb = 0; hb < 4; ++hb) { h8 qv[4];
#pragma unroll
                for (int d8 = 0; d8 < 4; ++d8) qv[d8] = *(const h8*)(qp + (hb * 4 + d8) * 8);
                __builtin_amdgcn_sched_barrier(0);
#pragma unroll
                for (int d8 = 0; d8 < 4; ++d8) {
#pragma unroll
                    for (int e = 0; e < 8; ++e) { const float qx = (float)qv[d8][e]; g0 += qx * KM[jj * 128 + (hb * 4 + d8) * 8 + e]; if (jj + 4 < cur) g1 += qx * KM[(jj + 4) * 128 + (hb * 4 + d8) * 8 + e]; } } }
        }
        GT[r * 8 + jj] = g0; GT[r * 8 + jj + 4] = g1;
    }
    __syncthreads();
    if (tid < 128) {
        unsigned m = 0u;
        if (cur <= 3) m = (1u << cur) - 1u;
        else {
            for (int k = 0; k < 3; ++k) { float best = -3.0e38f; int bi = 0;
                for (int j = 0; j < cur; ++j) { const float v = GT[tid * 8 + j]; if (!((m >> j) & 1u) && v > best) { best = v; bi = j; } }
                m |= 1u << bi; }
        }
        selm[tid] = m | (1u << cur);
        atomicOr((unsigned*)&misc[1], m);
    }
    __syncthreads();
    const unsigned vis = misc[1];
    int ntiles = 0;
    {
        const int own_t = (q0 + 128 - cur * 256) / 64;
        if (tid == 0) { int n = 0; for (int t = 0; t < own_t; ++t) tk0[n++] = cur * 256 + t * 64; for (int j = 0; j < cur; ++j) if ((vis >> j) & 1u) for (int t = 0; t < 4; ++t) tk0[n++] = j * 256 + t * 64; }
        ntiles = own_t + 4 * __popc(vis);
    }
    __syncthreads();
    const unsigned mysel = selm[wid * 16 + i];
    f32x4 O[8]; float ls;
    flash_core<128, true, true, false, true>(lds, MQ, MK, MVT, SQ, q0, ntiles, mysel, O, ls);
    const float inv = 1.0f / row_total(ls);
    hf* yp = Y + ((size_t)b * SQ + q0 + wid * 16 + i) * DM + 512 + h * 128;
#pragma unroll
    for (int dt = 0; dt < 8; ++dt) { h4 w;
#pragma unroll
        for (int j = 0; j < 4; ++j) w[j] = (hf)(O[dt][j] * inv);
        *(h4*)(yp + dt * 16 + g * 4) = w; }
}

__device__ __forceinline__ void mem_item(const Params& P, int l, LAS unsigned char* lds, int item) {
    const int tid = otid(), wid = __builtin_amdgcn_readfirstlane(tid >> 6), lane = tid & 63, i = lane & 15, g = lane >> 4;
    const int qt = item & 15, h = (item >> 4) & 3, b = item >> 6, q0 = qt * 128;
    const float* QF = (const float*)(P.ws + WS_BIG); hf* OM = (hf*)(P.ws + WS_OMEM);
    const hf* K = (const hf*)(P.ws + WS_MEMK) + (size_t)((l * 4 + b) * 4 + h) * 256 * 128; const hf* VT = (const hf*)(P.ws + WS_MEMVT) + (size_t)((l * 4 + b) * 4 + h) * 128 * 256;
    LAS int* tk0 = (LAS int*)(lds + A_TK0);
    if (tid < 4) tk0[tid] = tid * 64;
    { const int r = tid >> 2, qq = tid & 3; const float* qp = QF + ((size_t)b * SQ + q0 + r) * 512 + h * 128 + qq * 32; f32x4 v[8]; float ss = 0.f;
#pragma unroll
      for (int e = 0; e < 8; ++e) { v[e] = *(const f32x4*)(qp + e * 4); ss += v[e][0] * v[e][0] + v[e][1] * v[e][1] + v[e][2] * v[e][2] + v[e][3] * v[e][3]; }
      ss += __shfl_xor(ss, 1); ss += __shfl_xor(ss, 2);
      const float rr = rsqrtf(ss * (1.0f / 128) + 1e-6f) * (0.08838834764831845f * LOG2E); const float* gq = P.in[24] + l * 128 + qq * 32;
#pragma unroll
      for (int e = 0; e < 8; ++e) { const f32x4 gg = *(const f32x4*)(gq + e * 4); h4 w;
#pragma unroll
          for (int j = 0; j < 4; ++j) w[j] = (hf)(v[e][j] * rr * gg[j]);
          *(LAS h4*)(lds + A_QS + r * 272 + (qq * 32 + e * 4) * 2) = w; } }
    __syncthreads();
    f32x4 O[8]; float ls;
    flash_core<128, false, false, true, false>(lds, nullptr, K, VT, 256, q0, 4, 0xffffffffu, O, ls);
    const float inv = 1.0f / row_total(ls);
    hf* yp = OM + ((size_t)b * SQ + q0 + wid * 16 + i) * 512 + h * 128;
#pragma unroll
    for (int dt = 0; dt < 8; ++dt) { h4 w;
#pragma unroll
        for (int j = 0; j < 4; ++j) w[j] = (hf)(O[dt][j] * inv);
        *(h4*)(yp + dt * 16 + g * 4) = w; }
}

__device__ __forceinline__ int next_item(LAS unsigned char* lds, int* cnt) {
    LAS int* misc = (LAS int*)(lds + A_MISC);
    __syncthreads();
    if (threadIdx.x == 0) misc[0] = atomicAdd(cnt, 1);
    __syncthreads();
    return misc[0];
}

__global__ void __launch_bounds__(512, 2) fwd_mega(Params P) {
    extern __shared__ __attribute__((aligned(16))) unsigned char smem[];
    LAS unsigned char* lds = (LAS unsigned char*)smem;
    cg::grid_group grid = cg::this_grid();
    const int bid = blockIdx.x, nb = gridDim.x;
    const int lo = P.ph_lo, hi = P.ph_hi;
    int ph = 0;
#ifndef TIMING_MASK
#define TIMING_MASK 0
#endif
#ifndef TIMING_AMP
#define TIMING_AMP 4
#endif
    unsigned long long tsel = 0, tph0 = 0;
#define PHASE_BEGIN(cat) if (ph >= lo && ph < hi) { if (TIMING_MASK & (1 << (cat))) tph0 = __builtin_amdgcn_s_memrealtime();
#define PHASE_END(cat) if (ph + 1 < hi) grid.sync(); if (TIMING_MASK & (1 << (cat))) tsel += __builtin_amdgcn_s_memrealtime() - tph0; } ++ph;
    hf* H = (hf*)(P.ws + WS_H); hf* HID = (hf*)(P.ws + WS_BIG); float* PROJ = (float*)(P.ws + WS_BIG); hf* YC = (hf*)(P.ws + WS_YCAT); hf* OM = (hf*)(P.ws + WS_OMEM);
    int* CNT = (int*)(P.ws + WS_CNT);
    float* X = P.out;

    float* PSS = (float*)(P.ws + WS_PSS);
    LAS float* RS = (LAS float*)(lds + 131072);
    PHASE_BEGIN(0)
        if (bid == 0 && threadIdx.x < 64) CNT[threadIdx.x] = 0;
        convert_static(P, lds, bid, nb);
        for (int l = 0; l < NL; ++l) norm_rows(P.in[1], P.in[21] + l * DM, (hf*)(P.ws + WS_MEMH) + (size_t)l * 1024 * DM, 1024, bid, nb);
        norm_rows(P.in[0], P.in[3], H, MT, bid, nb, PSS);
    PHASE_END(0)

    constexpr int QG = 4;
    for (int l = 0; l < NL; ++l) {
        const hf* W = (const hf*)(P.ws + WS_W) + (size_t)l * E_LAYER;
        const float* xin = (l == 0) ? P.in[0] : X;
        PHASE_BEGIN(1)
            { pg8::Gemm g{H, W + O_GU1, MT, 2 * DFF, DM}; pg8::StaticOrder S; S.init(MT, 2 * DFF, nb, bid); pg8::fill_rs(RS, PSS, S); pg8::EpiSwiGLU E{HID, DFF, RS}; pg8::gemm_phase(lds, g, S, E); }
            conv_pull(P, lds, l == 0 ? 704 : 6272, bid >= 128 ? QG : 0);
        PHASE_END(1)
        PHASE_BEGIN(2)
            { pg8::Gemm g{HID, W + O_DN1, MT, DM, DFF}; pg8::StaticOrder S; S.init(MT, DM, nb, bid); pg8::EpiRes E{xin, X, P.in[7] + l * DM, H, PSS, DM, 0.5f}; pg8::gemm_phase(lds, g, S, E); }
            conv_pull(P, lds, l == 0 ? 1664 : 6976, 0);
        PHASE_END(2)
        PHASE_BEGIN(4)
            { pg8::Gemm g{H, W + O_WIN, MT, PW, DM}; pg8::StaticOrder S; S.init(MT, PW, nb, bid); pg8::fill_rs(RS, PSS, S); pg8::EpiH16 E{(hf*)(P.ws + WS_BIG), PW, RS}; pg8::gemm_phase(lds, g, S, E); }
            if (l == 0) {
                for (int l2 = 0; l2 < NL; ++l2) { pg8::Gemm g{(const hf*)(P.ws + WS_MEMH) + (size_t)l2 * 1024 * DM, (const hf*)(P.ws + WS_W) + (size_t)l2 * E_LAYER + O_WKV, 1024, 1024, DM};
                    pg8::StaticOrder S; S.init(1024, 1024, nb, (bid + nb - 192 - 16 * l2) % nb); pg8::EpiF32 E{(float*)(P.ws + WS_MEMKV) + (size_t)l2 * 1024 * 1024, 1024, nullptr}; pg8::gemm_phase(lds, g, S, E); }
            }
            conv_pull(P, lds, l == 0 ? 1920 : 7232, (bid >= (l == 0 ? 224 : 192)) ? QG : 0);
        PHASE_END(4)
        PHASE_BEGIN(5)
            post_proj(P, l, lds, bid, nb);
            if (l == 0) memkv_post(P, bid, nb);
        PHASE_END(5)
        PHASE_BEGIN(6)
            { const int xg = bid & 7;
              for (;;) {
                const int it = next_item(lds, CNT + 16 + l * 8 + xg);
                if (it >= 96 + 64) break;
                if (it < 96) { const int rnd = it / 6, w = it % 6, qt = 15 - rnd, bh = xg * 3 + (w % 3); if (w < 3) diff_item(P, l, lds, bh, qt); else moba_item(P, l, lds, bh, qt); }
                else conv_item(P, l, lds, xg * 64 + (it - 96));
              } }
        PHASE_END(6)
        PHASE_BEGIN(7)
            { pg8::Gemm g{YC, W + O_WOUT, MT, DM, DM}; pg8::StaticOrder S; S.init(MT, DM, nb, bid); pg8::EpiRes E{X, X, P.in[20] + l * DM, H, PSS, DM, 1.0f}; pg8::gemm_phase(lds, g, S, E); }
            conv_pull(P, lds, l == 0 ? 1984 : 7296, 0);
        PHASE_END(7)
        PHASE_BEGIN(8)
            { pg8::Gemm g{H, W + O_WQ, MT, 512, DM}; pg8::StaticOrder S; S.init(MT, 512, nb, bid); pg8::fill_rs(RS, PSS, S); pg8::EpiF32 E{(float*)(P.ws + WS_BIG), 512, RS}; pg8::gemm_phase(lds, g, S, E); }
            conv_pull(P, lds, l == 0 ? 2048 : 7360, bid >= 64 ? QG : 0);
        PHASE_END(8)
        PHASE_BEGIN(9)
            for (int it = bid; it < 256; it += nb) { __syncthreads(); mem_item(P, l, lds, it); }
        PHASE_END(9)
        PHASE_BEGIN(10)
            { pg8::Gemm g{OM, W + O_WO, MT, DM, 512}; pg8::StaticOrder S; S.init(MT, DM, nb, bid); pg8::EpiRes E{X, X, P.in[27] + l * DM, H, PSS, DM, 1.0f}; pg8::gemm_phase(lds, g, S, E); }
            conv_pull(P, lds, l == 0 ? 3456 : 8768, 0);
        PHASE_END(10)
        PHASE_BEGIN(1)
            { pg8::Gemm g{H, W + O_GU2, MT, 2 * DFF, DM}; pg8::StaticOrder S; S.init(MT, 2 * DFF, nb, bid); pg8::fill_rs(RS, PSS, S); pg8::EpiSwiGLU E{HID, DFF, RS}; pg8::gemm_phase(lds, g, S, E); }
            conv_pull(P, lds, l == 0 ? 4160 : 9472, bid >= 128 ? QG : 0);
        PHASE_END(1)
        PHASE_BEGIN(2)
            { pg8::Gemm g{HID, W + O_DN2, MT, DM, DFF}; pg8::StaticOrder S; S.init(MT, DM, nb, bid); pg8::EpiRes E{X, X, (l + 1 < NL) ? P.in[3] + (l + 1) * DM : nullptr, H, PSS, DM, 0.5f}; pg8::gemm_phase(lds, g, S, E); }
            if (l + 1 < NL) conv_pull(P, lds, 5568, 0);
        PHASE_END(2)
    }
    if (TIMING_MASK != 0 && bid == 0 && threadIdx.x == 0) { const unsigned long long t1 = __builtin_amdgcn_s_memrealtime(); while (__builtin_amdgcn_s_memrealtime() - t1 < (unsigned long long)TIMING_AMP * tsel) __builtin_amdgcn_s_sleep(8); }
}

extern "C" void kernel_launch(void* const* d_in, const int* in_sizes, int n_in, void* d_out, int out_size, void* d_ws, size_t ws_size, hipStream_t stream) {
    static int grid_blocks = 0;
    if (grid_blocks == 0) {
        if (n_in != 31 || out_size != MT * DM || ws_size < WS_END) { fprintf(stderr, "kernel_launch: unexpected shapes (n_in %d out %d ws %zu need %zu)\n", n_in, out_size, ws_size, (size_t)WS_END); grid_blocks = -1; return; }
        int dev = 0, cus = 0, per_cu = 0;
        hipGetDevice(&dev);
        hipDeviceGetAttribute(&cus, hipDeviceAttributeMultiprocessorCount, dev);
        if (hipFuncSetAttribute((const void*)fwd_mega, hipFuncAttributeMaxDynamicSharedMemorySize, LDS_BYTES) != hipSuccess) { fprintf(stderr, "hipFuncSetAttribute failed\n"); grid_blocks = -1; return; }
        hipOccupancyMaxActiveBlocksPerMultiprocessor(&per_cu, (const void*)fwd_mega, 512, LDS_BYTES);
        if (per_cu < 1) { fprintf(stderr, "occupancy query says %d blocks per CU\n", per_cu); per_cu = 1; }
        (void)hipGetLastError();
        grid_blocks = cus;
    }
    if (grid_blocks < 0) return;
    Params p{};
    for (int i = 0; i < 31; ++i) p.in[i] = (const float*)d_in[i];
    p.out = (float*)d_out; p.ws = (unsigned char*)d_ws; p.ph_lo = 0; p.ph_hi = 1000;
    void* args[] = {&p};
    hipError_t e = hipLaunchCooperativeKernel((const void*)fwd_mega, dim3(grid_blocks), dim3(512), args, LDS_BYTES, stream);
    if (e != hipSuccess) fprintf(stderr, "cooperative launch failed: %s (grid %d)\n", hipGetErrorString(e), grid_blocks);
}
```
